# Optimizing an MI355X kernel written in HIP

```python
import math
import jax
import jax.numpy as jnp
from jax import lax
import numpy as np

D_MODEL = 1024
BATCH = 4
SEQ = 4096
DEPTH = 2

EPS = 1e-6
CONV_K = 4

SSD_WIDTH = D_MODEL
SSD_HEAD_DIM = 64
SSD_HEADS = SSD_WIDTH // SSD_HEAD_DIM
SSD_GROUPS = 2
SSD_STATE = 128
SSD_CHUNK = 128
SSD_CONV_DIM = SSD_WIDTH + 2 * SSD_GROUPS * SSD_STATE

ML_WIDTH = D_MODEL // 2
ML_HEADS = 4
ML_HEAD_DIM = ML_WIDTH // ML_HEADS
ML_CHUNK = 128

HG_WIDTH = D_MODEL // 2
HG_HEADS = 4
HG_HEAD_DIM = HG_WIDTH // HG_HEADS
HG_CHUNK = 16

IN_SPLITS = (SSD_WIDTH, SSD_GROUPS * SSD_STATE, SSD_GROUPS * SSD_STATE, SSD_HEADS, SSD_WIDTH,
             ML_WIDTH, ML_WIDTH, ML_WIDTH,
             HG_WIDTH, HG_WIDTH, HG_WIDTH, HG_WIDTH,
             D_MODEL, D_MODEL, D_MODEL)
N_IN = sum(IN_SPLITS)

kernel_name = 'hybrid_ssd_mlstm_hgrn2'


def rmsnorm(x, w):
    xf = x.astype(jnp.float32)
    y = xf * lax.rsqrt(jnp.mean(xf * xf, -1, keepdims=True) + EPS)
    return (y * w).astype(x.dtype)


def grouped_rmsnorm(x, w, groups):
    sh = x.shape
    xf = x.astype(jnp.float32).reshape(*sh[:-1], groups, sh[-1] // groups)
    y = xf * lax.rsqrt(jnp.mean(xf * xf, -1, keepdims=True) + EPS)
    return y.reshape(sh) * w


def head_layernorm(x, w):
    xf = x.astype(jnp.float32)
    mu = jnp.mean(xf, -1, keepdims=True)
    xc = xf - mu
    y = xc * lax.rsqrt(jnp.mean(xc * xc, -1, keepdims=True) + EPS)
    b, t, h, d = x.shape
    return y.reshape(b, t, h * d) * w


def causal_dwconv(x, w, bias):
    k = w.shape[0]
    y = lax.conv_general_dilated(x, w[:, None, :], window_strides=(1,), padding=[(k - 1, 0)],
                                 dimension_numbers=('NWC', 'WIO', 'NWC'),
                                 feature_group_count=x.shape[-1])
    return y + bias


def causal_log_decay(a):
    cs = jnp.cumsum(a, -1)
    n = a.shape[-1]
    mask = jnp.tril(jnp.ones((n, n), dtype=bool))
    return jnp.where(mask, cs[..., :, None] - cs[..., None, :], -jnp.inf)


def scan_chunk_states(decay, local):
    def step(s, inp):
        d, l = inp
        return d * s + l, s
    _, s_in = lax.scan(step, jnp.zeros_like(local[0]), (decay, local))
    return s_in


def ssd_scan(xs, bm, cm, dt_raw, dt_bias, a_log, d_skip):
    f32 = jnp.float32
    b, t, h, p = xs.shape
    g, n = bm.shape[2], bm.shape[3]
    hg = h // g
    nc = t // SSD_CHUNK
    dt = jax.nn.softplus(dt_raw.astype(f32) + dt_bias.astype(f32))
    a = -jnp.exp(a_log.astype(f32))
    la = (dt * a).reshape(b, nc, SSD_CHUNK, g, hg).transpose(0, 3, 4, 1, 2)
    cum = jnp.cumsum(la, -1)
    x_dt = (xs.astype(f32) * dt[..., None]).reshape(b, nc, SSD_CHUNK, g, hg, p)
    bc = bm.astype(f32).reshape(b, nc, SSD_CHUNK, g, n)
    cc = cm.astype(f32).reshape(b, nc, SSD_CHUNK, g, n)
    cb = jnp.einsum('bclgn,bcsgn->bgcls', cc, bc)
    scores = cb[:, :, None] * jnp.exp(causal_log_decay(la))
    y_diag = jnp.einsum('bghcls,bcsghp->bclghp', scores, x_dt)
    w_end = jnp.exp(cum[..., -1:] - cum)
    local = jnp.einsum('bcsgn,bghcs,bcsghp->cbghpn', bc, w_end, x_dt)
    chunk_decay = jnp.exp(cum[..., -1]).transpose(3, 0, 1, 2)[..., None, None]
    s_in = scan_chunk_states(chunk_decay, local)
    y_off = jnp.einsum('bclgn,cbghpn,bghcl->bclghp', cc, s_in, jnp.exp(cum))
    y = (y_diag + y_off).reshape(b, t, h, p)
    return y + xs.astype(f32) * d_skip.astype(f32)[:, None]


def mlstm_scan(q, k, v, i_pre, f_pre):
    f32 = jnp.float32
    b, t, h, d = q.shape
    L = ML_CHUNK
    nc = t // L
    qc = (q.astype(f32) * (d ** -0.5)).reshape(b, nc, L, h, d)
    kc = k.astype(f32).reshape(b, nc, L, h, d)
    vc = v.astype(f32).reshape(b, nc, L, h, d)
    li = i_pre.astype(f32).reshape(b, nc, L, h).transpose(0, 3, 1, 2)
    lf = jax.nn.log_sigmoid(f_pre.astype(f32)).reshape(b, nc, L, h).transpose(0, 3, 1, 2)
    cum = jnp.cumsum(lf, -1)
    log_d = causal_log_decay(lf) + li[..., None, :]
    log_end = cum[..., -1:] - cum + li
    m_loc = jnp.max(log_end, -1)
    w_end = jnp.exp(log_end - m_loc[..., None])
    c_loc = jnp.einsum('bhcs,bcshd,bcshe->cbhde', w_end, vc, kc)
    n_loc = jnp.einsum('bhcs,bcshe->cbhe', w_end, kc)
    g_end = cum[..., -1].transpose(2, 0, 1)
    m_loc_c = m_loc.transpose(2, 0, 1)

    def step(carry, inp):
        c_s, n_s, m_s = carry
        g, ml, cl, nl = inp
        m_new = jnp.maximum(g + m_s, ml)
        a_old = jnp.exp(g + m_s - m_new)
        a_loc = jnp.exp(ml - m_new)
        c_new = a_old[..., None, None] * c_s + a_loc[..., None, None] * cl
        n_new = a_old[..., None] * n_s + a_loc[..., None] * nl
        return (c_new, n_new, m_new), (c_s, n_s, m_s)

    init = (jnp.zeros((b, h, d, d), f32), jnp.zeros((b, h, d), f32), jnp.zeros((b, h), f32))
    _, (c_in, n_in, m_in) = lax.scan(step, init, (g_end, m_loc_c, c_loc, n_loc))
    m_in = m_in.transpose(1, 2, 0)
    log_inter = cum + m_in[..., None]
    m_t = jnp.maximum(log_inter, jnp.max(log_d, -1))
    w_intra = jnp.exp(log_d - m_t[..., None])
    w_inter = jnp.exp(log_inter - m_t)
    s = jnp.einsum('bclhe,bcshe->bhcls', qc, kc) * w_intra
    num = (jnp.einsum('bhcls,bcshd->bclhd', s, vc)
           + jnp.einsum('bclhe,cbhde,bhcl->bclhd', qc, c_in, w_inter))
    den = jnp.sum(s, -1) + jnp.einsum('bclhe,cbhe,bhcl->bhcl', qc, n_in, w_inter)
    den = jnp.maximum(jnp.abs(den), jnp.exp(-m_t))
    out = num / den.transpose(0, 2, 3, 1)[..., None]
    return out.reshape(b, t, h, d)


def hgrn2_scan(q, k, v, log_f):
    f32 = jnp.float32
    b, t, h, dk = q.shape
    dv = v.shape[-1]
    L = HG_CHUNK
    nc = t // L
    qc = q.astype(f32).reshape(b, nc, L, h, dk)
    kc = k.astype(f32).reshape(b, nc, L, h, dk)
    vc = v.astype(f32).reshape(b, nc, L, h, dv)
    cum = jnp.cumsum(log_f.astype(f32).reshape(b, nc, L, h, dk), axis=2)
    mask = jnp.tril(jnp.ones((L, L), dtype=bool))[None, None, :, :, None, None]
    diff = cum[:, :, :, None] - cum[:, :, None, :]
    dec = jnp.exp(jnp.where(mask, diff, -jnp.inf))
    attn = jnp.einsum('bclhk,bcshk,bclshk->bchls', qc, kc, dec)
    y_intra = jnp.einsum('bchls,bcshv->bclhv', attn, vc)
    w_end = jnp.exp(cum[:, :, -1:] - cum)
    local = jnp.einsum('bcshk,bcshv->cbhkv', kc * w_end, vc)
    chunk_decay = jnp.exp(cum[:, :, -1]).transpose(1, 0, 2, 3)[..., None]
    s_in = scan_chunk_states(chunk_decay, local)
    y_inter = jnp.einsum('bclhk,cbhkv->bclhv', qc * jnp.exp(cum), s_in)
    return (y_intra + y_inter).reshape(b, t, h, dv)


def hybrid_layer(x, lb, norm_w, w_in, ssd_conv_w, ssd_conv_b, ssd_dt_bias, ssd_a_log, ssd_d,
                 ssd_norm_w, ml_conv_w, ml_conv_b, ml_wq, ml_wk, ml_wv, ml_w_if, ml_b_if,
                 ml_norm_w, ml_skip, hg_norm_w, w_branch_ssd, w_branch_ml, w_branch_hg, w_out):
    f32 = jnp.float32
    b, t, _ = x.shape
    hn = rmsnorm(x, norm_w)
    proj = hn @ w_in
    split_points = [int(v) for v in np.cumsum(IN_SPLITS)[:-1]]
    (s_x, s_b, s_c, s_dt, s_z, m_x, m_o, m_z, g_q, g_f, g_i, g_z,
     gate_ssd, gate_ml, gate_hg) = jnp.split(proj, split_points, axis=-1)

    xbc = jax.nn.silu(causal_dwconv(jnp.concatenate([s_x, s_b, s_c], -1), ssd_conv_w, ssd_conv_b))
    sx, sb, sc = jnp.split(xbc, [SSD_WIDTH, SSD_WIDTH + SSD_GROUPS * SSD_STATE], axis=-1)
    y_ssd = ssd_scan(sx.reshape(b, t, SSD_HEADS, SSD_HEAD_DIM),
                     sb.reshape(b, t, SSD_GROUPS, SSD_STATE),
                     sc.reshape(b, t, SSD_GROUPS, SSD_STATE),
                     s_dt, ssd_dt_bias, ssd_a_log, ssd_d)
    y_ssd = grouped_rmsnorm(y_ssd.reshape(b, t, SSD_WIDTH) * jax.nn.silu(s_z.astype(f32)),
                            ssd_norm_w, SSD_GROUPS)

    m_conv = jax.nn.silu(causal_dwconv(m_x, ml_conv_w, ml_conv_b))
    xc_h = m_conv.reshape(b, t, ML_HEADS, ML_HEAD_DIM)
    q = jnp.einsum('bthd,hde->bthe', xc_h, ml_wq)
    k = jnp.einsum('bthd,hde->bthe', xc_h, ml_wk)
    v = jnp.einsum('bthd,hde->bthe', m_x.reshape(b, t, ML_HEADS, ML_HEAD_DIM), ml_wv)
    qkv = jnp.concatenate([q, k, v], -1).reshape(b, t, 3 * ML_WIDTH)
    if_pre = qkv @ ml_w_if + ml_b_if
    i_pre, f_pre = jnp.split(if_pre, 2, axis=-1)
    h_ml = mlstm_scan(q, k, v, i_pre, f_pre)
    y_ml = (head_layernorm(h_ml, ml_norm_w) * jax.nn.sigmoid(m_o.astype(f32))
            + ml_skip * m_conv.astype(f32))
    y_ml = y_ml * jax.nn.silu(m_z.astype(f32))

    fx = g_f.astype(f32)
    log_f = jnp.logaddexp(jax.nn.log_sigmoid(fx), jnp.log(lb) + jax.nn.log_sigmoid(-fx))
    k_hg = (1.0 - lb) * jax.nn.sigmoid(-fx)
    q_hg = jax.nn.silu(g_q.astype(f32))
    o_hg = hgrn2_scan(q_hg.reshape(b, t, HG_HEADS, HG_HEAD_DIM),
                      k_hg.reshape(b, t, HG_HEADS, HG_HEAD_DIM),
                      g_i.reshape(b, t, HG_HEADS, HG_HEAD_DIM),
                      log_f.reshape(b, t, HG_HEADS, HG_HEAD_DIM))
    y_hg = grouped_rmsnorm(o_hg.reshape(b, t, HG_WIDTH), hg_norm_w, HG_HEADS) * jax.nn.silu(g_z.astype(f32))

    dt_ = x.dtype
    merged = (jax.nn.sigmoid(gate_ssd) * (y_ssd.astype(dt_) @ w_branch_ssd)
              + jax.nn.sigmoid(gate_ml) * (y_ml.astype(dt_) @ w_branch_ml)
              + jax.nn.sigmoid(gate_hg) * (y_hg.astype(dt_) @ w_branch_hg))
    return x + (merged @ w_out).astype(dt_)


def setup_inputs(seed: int = 0) -> dict:
    key = jax.random.key(seed)
    ks = jax.random.split(key, 26)
    f32 = jnp.float32

    def nrm(k, shape, scale):
        return jax.random.normal(k, shape, f32) * scale

    def gain(k, shape):
        return 1.0 + 0.02 * jax.random.normal(k, shape, f32)

    x = nrm(ks[0], (BATCH, SEQ, D_MODEL), 1.0)
    norm_w = gain(ks[1], (DEPTH, D_MODEL))
    w_in = nrm(ks[2], (DEPTH, D_MODEL, N_IN), D_MODEL ** -0.5)
    ssd_conv_w = nrm(ks[3], (DEPTH, CONV_K, SSD_CONV_DIM), CONV_K ** -0.5)
    ssd_conv_b = nrm(ks[4], (DEPTH, SSD_CONV_DIM), 0.02)
    dt0 = jnp.exp(jax.random.uniform(ks[5], (DEPTH, SSD_HEADS), f32, math.log(1e-3), math.log(1e-1)))
    ssd_dt_bias = dt0 + jnp.log(-jnp.expm1(-dt0))
    ssd_a_log = jnp.log(jax.random.uniform(ks[6], (DEPTH, SSD_HEADS), f32, 1.0, 16.0))
    ssd_d = gain(ks[7], (DEPTH, SSD_HEADS))
    ssd_norm_w = gain(ks[8], (DEPTH, SSD_WIDTH))
    ml_conv_w = nrm(ks[9], (DEPTH, CONV_K, ML_WIDTH), CONV_K ** -0.5)
    ml_conv_b = nrm(ks[10], (DEPTH, ML_WIDTH), 0.02)
    ml_wq = nrm(ks[11], (DEPTH, ML_HEADS, ML_HEAD_DIM, ML_HEAD_DIM), ML_HEAD_DIM ** -0.5)
    ml_wk = nrm(ks[12], (DEPTH, ML_HEADS, ML_HEAD_DIM, ML_HEAD_DIM), ML_HEAD_DIM ** -0.5)
    ml_wv = nrm(ks[13], (DEPTH, ML_HEADS, ML_HEAD_DIM, ML_HEAD_DIM), ML_HEAD_DIM ** -0.5)
    ml_w_if = nrm(ks[14], (DEPTH, 3 * ML_WIDTH, 2 * ML_HEADS), (3 * ML_WIDTH) ** -0.5)
    i_bias = nrm(ks[15], (DEPTH, ML_HEADS), 0.1)
    f_bias = jnp.linspace(3.0, 6.0, ML_HEADS, dtype=f32)[None] + nrm(ks[16], (DEPTH, ML_HEADS), 0.02)
    ml_b_if = jnp.concatenate([i_bias, f_bias], -1)
    ml_norm_w = gain(ks[17], (DEPTH, ML_WIDTH))
    ml_skip = gain(ks[18], (DEPTH, ML_WIDTH))
    hg_lower_bounds = nrm(ks[19], (DEPTH, HG_WIDTH), 0.1)
    hg_norm_w = gain(ks[20], (DEPTH, HG_WIDTH))
    w_branch_ssd = nrm(ks[21], (DEPTH, SSD_WIDTH, D_MODEL), SSD_WIDTH ** -0.5)
    w_branch_ml = nrm(ks[22], (DEPTH, ML_WIDTH, D_MODEL), ML_WIDTH ** -0.5)
    w_branch_hg = nrm(ks[23], (DEPTH, HG_WIDTH, D_MODEL), HG_WIDTH ** -0.5)
    w_out = nrm(ks[24], (DEPTH, D_MODEL, D_MODEL), D_MODEL ** -0.5)
    final_norm_w = gain(ks[25], (D_MODEL,))
    return {'x': x, 'norm_w': norm_w, 'w_in': w_in, 'ssd_conv_w': ssd_conv_w,
            'ssd_conv_b': ssd_conv_b, 'ssd_dt_bias': ssd_dt_bias, 'ssd_a_log': ssd_a_log,
            'ssd_d': ssd_d, 'ssd_norm_w': ssd_norm_w, 'ml_conv_w': ml_conv_w,
            'ml_conv_b': ml_conv_b, 'ml_wq': ml_wq, 'ml_wk': ml_wk, 'ml_wv': ml_wv,
            'ml_w_if': ml_w_if, 'ml_b_if': ml_b_if, 'ml_norm_w': ml_norm_w, 'ml_skip': ml_skip,
            'hg_lower_bounds': hg_lower_bounds, 'hg_norm_w': hg_norm_w,
            'w_branch_ssd': w_branch_ssd, 'w_branch_ml': w_branch_ml, 'w_branch_hg': w_branch_hg,
            'w_out': w_out, 'final_norm_w': final_norm_w}


def reference(x, norm_w, w_in, ssd_conv_w, ssd_conv_b, ssd_dt_bias, ssd_a_log, ssd_d, ssd_norm_w,
              ml_conv_w, ml_conv_b, ml_wq, ml_wk, ml_wv, ml_w_if, ml_b_if, ml_norm_w, ml_skip,
              hg_lower_bounds, hg_norm_w, w_branch_ssd, w_branch_ml, w_branch_hg, w_out,
              final_norm_w):
    lbs = jnp.cumsum(jax.nn.softmax(hg_lower_bounds.astype(jnp.float32), axis=0), axis=0)
    lbs = lbs - lbs[0]
    for l in range(DEPTH):
        x = hybrid_layer(x, lbs[l], norm_w[l], w_in[l], ssd_conv_w[l], ssd_conv_b[l],
                         ssd_dt_bias[l], ssd_a_log[l], ssd_d[l], ssd_norm_w[l],
                         ml_conv_w[l], ml_conv_b[l], ml_wq[l], ml_wk[l], ml_wv[l],
                         ml_w_if[l], ml_b_if[l], ml_norm_w[l], ml_skip[l], hg_norm_w[l],
                         w_branch_ssd[l], w_branch_ml[l], w_branch_hg[l], w_out[l])
    return rmsnorm(x, final_norm_w)
```

```cpp
#include <hip/hip_runtime.h>
#include <cstdio>
#include <cstdint>
#include <cmath>

#ifndef C0SKIP
#define C0SKIP 0
#endif
#ifndef PROBE_SCAN
#define PROBE_SCAN 3
#endif
#ifndef PROBE_POST
#define PROBE_POST 4
#endif
#ifndef PROBE_IMASK
#define PROBE_IMASK 7
#endif
#ifndef PROBE_K
#define PROBE_K 0
#endif
#ifndef FMASK
#define FMASK 0x1ff
#endif
#ifndef FUSED_UNROLL_LAYERS
#define FUSED_UNROLL_LAYERS 0
#endif
#ifndef MK_PER_PHASE
#define MK_PER_PHASE 0
#endif

namespace pg8 {
#define PG8_LAS __attribute__((address_space(3)))
typedef unsigned short bf16_t;
typedef short bf16x8 __attribute__((ext_vector_type(8)));
typedef float f32x4 __attribute__((ext_vector_type(4)));
typedef unsigned u32x4 __attribute__((ext_vector_type(4)));
constexpr int BM = 256, BK = 64, HALF = 128, HTB = HALF * BK * 2  , STAGE_BYTES = 8 * HTB, NXCD = 8, WGM = 8;

__host__ __device__ __forceinline__ int lds_byte(int r, int c) { const int st = (r >> 4) * 2 + (c >> 5), rr = r & 15, cc = c & 31, ob = rr * 64 + cc * 2; return st * 1024 + (ob ^ (((ob >> 9) & 1) << 5)); }
__host__ __device__ __forceinline__ void stage_rc(int b, int& R, int& C) { const int st = b / 1024, sb = b % 1024, swz = sb ^ (((sb >> 9) & 1) << 5); R = (st >> 1) * 16 + swz / 64; C = (st & 1) * 32 + (swz % 64) / 2; }
__host__ __device__ __forceinline__ int perm32(int rho) { const int n = rho >> 4, i = rho & 15; return 8 * (i >> 2) + 4 * n + (i & 3); }

struct Unit { int pm, pn, ka, kb, nt, tag; };
struct Gemm { const bf16_t* A; const bf16_t* Bt; int lda, ldb; };

struct StaticOrder {
    int nM, nN, nwg, G, c, nt;
    __host__ __device__ void init(int M, int N, int K, int G_, int c_) { nM = M / BM; nN = N / BM; nwg = nM * nN; G = G_; c = c_; nt = K / BK; }
    __host__ __device__ void map(int wgid, int& pm, int& pn) const {
        { const int q = nwg / NXCD, r = nwg % NXCD, xcd = wgid % NXCD, off = wgid / NXCD; wgid = (xcd < r ? xcd * (q + 1) : r * (q + 1) + (xcd - r) * q) + off; }
        const int nig = WGM * nN, gid = wgid / nig, fm = gid * WGM, gsz = (nM - fm) < WGM ? (nM - fm) : WGM;
        pm = fm + ((wgid % nig) % gsz); pn = (wgid % nig) / gsz;
    }
    __host__ __device__ bool next(int i, Unit& u) const {
        const long L = (long)i * G + c; if (L >= nwg) return false;
        map((int)L, u.pm, u.pn); u.ka = 0; u.kb = 0; u.nt = nt; u.tag = 0; return true;
    }
    __device__ __forceinline__ void a_ready(const Unit&) const {}
    __device__ __forceinline__ void done(const Unit&) const {}
};
struct BranchOrder {
    StaticOrder so;
    __host__ __device__ void init(int M, int N, int G_, int c_) { so.init(M, N, 1024, G_, c_); }
    __host__ __device__ bool next(int i, Unit& u) const {
        const int j = i / 3, br = i - 3 * j;
        const long L = (long)j * so.G + so.c; if (L >= so.nwg) return false;
        so.map((int)L, u.pm, u.pn);
        const int koff = br == 0 ? 0 : (br == 1 ? 1024 : 1536);
        u.ka = koff * 2; u.kb = koff * 2; u.nt = br == 0 ? 16 : 8; u.tag = br; return true;
    }
    __device__ __forceinline__ void a_ready(const Unit&) const {}
    __device__ __forceinline__ void done(const Unit&) const {}
};

typedef __bf16 pbf16x2 __attribute__((ext_vector_type(2)));
typedef float pf32x2 __attribute__((ext_vector_type(2)));
__device__ __forceinline__ unsigned cvt_pk_bf16(float lo, float hi) { const pf32x2 v = {lo, hi}; return __builtin_bit_cast(unsigned, __builtin_convertvector(v, pbf16x2)); }
__device__ __forceinline__ float bflo(unsigned w) { return __uint_as_float(w << 16); }
__device__ __forceinline__ float bfhi(unsigned w) { return __uint_as_float(w & 0xffff0000u); }
__device__ __forceinline__ float sigmoidf_(float x) { return __builtin_amdgcn_rcpf(1.0f + __expf(-x)); }

struct EpiProj {
    static constexpr bool PERM = true, AFTER_DRAIN = false;
    bf16_t* O; int ldc; bf16_t* halo; int halo_cols; int act;
    __device__ __forceinline__ void operator()(const f32x4 (&acc)[2][2][4][2], const Unit& u, int wr, int wc, int fr, int fq) const {
        const int row0 = u.pm * BM + wr * 64 + fr, col0 = u.pn * BM + wc * 32 + 8 * fq;
        const bool do_halo = halo != nullptr && (u.pn * BM < halo_cols) && fr >= 13;
#pragma unroll
        for (int ai = 0; ai < 2; ++ai)
#pragma unroll
            for (int m = 0; m < 4; ++m) { const int row = row0 + ai * HALF + m * 16; bf16_t* rowp = O + (size_t)row * ldc + col0;
#pragma unroll
                for (int bj = 0; bj < 2; ++bj) { f32x4 v0 = acc[ai][bj][m][0], v1 = acc[ai][bj][m][1];
                    if (act == 1) {
#pragma unroll
                        for (int e = 0; e < 4; ++e) { v0[e] = sigmoidf_(v0[e]); v1[e] = sigmoidf_(v1[e]); } }
                    u32x4 w; w.x = cvt_pk_bf16(v0[0], v0[1]); w.y = cvt_pk_bf16(v0[2], v0[3]); w.z = cvt_pk_bf16(v1[0], v1[1]); w.w = cvt_pk_bf16(v1[2], v1[3]);
                    *(u32x4*)(rowp + bj * HALF) = w;
                    if (m == 3 && do_halo) *(u32x4*)(halo + ((size_t)(row >> 6) * 3 + (fr - 13)) * halo_cols + col0 + bj * HALF) = w; } }
    }
};
struct EpiMerge {
    static constexpr bool PERM = true, AFTER_DRAIN = false;
    bf16_t* O; int ldc; const bf16_t* G; int ldg;
    __device__ __forceinline__ void operator()(const f32x4 (&acc)[2][2][4][2], const Unit& u, int wr, int wc, int fr, int fq) const {
        const int row0 = u.pm * BM + wr * 64 + fr, col0 = u.pn * BM + wc * 32 + 8 * fq;
#pragma unroll
        for (int ai = 0; ai < 2; ++ai)
#pragma unroll
            for (int mh = 0; mh < 2; ++mh) {
                u32x4 gq[2][2], pq[2][2];
#pragma unroll
                for (int m2 = 0; m2 < 2; ++m2) { const int row = row0 + ai * HALF + (2 * mh + m2) * 16;
#pragma unroll
                    for (int bj = 0; bj < 2; ++bj) { gq[m2][bj] = *(const u32x4*)(G + (size_t)row * ldg + u.tag * 1024 + col0 + bj * HALF);
                        pq[m2][bj] = (u.tag != 0) ? *(const u32x4*)(O + (size_t)row * ldc + col0 + bj * HALF) : (u32x4){0u, 0u, 0u, 0u}; } }
                asm volatile("" ::: "memory");
#pragma unroll
                for (int m2 = 0; m2 < 2; ++m2) { const int m = 2 * mh + m2; const int row = row0 + ai * HALF + m * 16; bf16_t* rowp = O + (size_t)row * ldc + col0;
#pragma unroll
                    for (int bj = 0; bj < 2; ++bj) { const f32x4 v0 = acc[ai][bj][m][0], v1 = acc[ai][bj][m][1];
                        const u32x4 g = gq[m2][bj], p = pq[m2][bj];
                        float o[8];
                        o[0] = bflo(p.x); o[1] = bfhi(p.x); o[2] = bflo(p.y); o[3] = bfhi(p.y); o[4] = bflo(p.z); o[5] = bfhi(p.z); o[6] = bflo(p.w); o[7] = bfhi(p.w);
                        o[0] += bflo(g.x) * v0[0]; o[1] += bfhi(g.x) * v0[1]; o[2] += bflo(g.y) * v0[2]; o[3] += bfhi(g.y) * v0[3];
                        o[4] += bflo(g.z) * v1[0]; o[5] += bfhi(g.z) * v1[1]; o[6] += bflo(g.w) * v1[2]; o[7] += bfhi(g.w) * v1[3];
                        u32x4 w; w.x = cvt_pk_bf16(o[0], o[1]); w.y = cvt_pk_bf16(o[2], o[3]); w.z = cvt_pk_bf16(o[4], o[5]); w.w = cvt_pk_bf16(o[6], o[7]);
                        *(u32x4*)(rowp + bj * HALF) = w; } }
            }
    }
};
struct EpiResid {
    static constexpr bool PERM = false, AFTER_DRAIN = false;
    const float* base; float* out; int ldc;
    __device__ __forceinline__ void operator()(const f32x4 (&acc)[2][2][4][2], const Unit& u, int wr, int wc, int fr, int fq) const {
        const int row0 = u.pm * BM + wr * 64 + fr, col0 = u.pn * BM + wc * 32 + 4 * fq;
#pragma unroll
        for (int ai = 0; ai < 2; ++ai)
#pragma unroll
            for (int mh = 0; mh < 2; ++mh) {
                f32x4 bs[2][2][2];
#pragma unroll
                for (int m2 = 0; m2 < 2; ++m2) { const size_t off = (size_t)(row0 + ai * HALF + (2 * mh + m2) * 16) * ldc + col0;
#pragma unroll
                    for (int bj = 0; bj < 2; ++bj)
#pragma unroll
                        for (int n = 0; n < 2; ++n) bs[m2][bj][n] = *(const f32x4*)(base + off + bj * HALF + n * 16); }
                asm volatile("" ::: "memory");
#pragma unroll
                for (int m2 = 0; m2 < 2; ++m2) { const size_t off = (size_t)(row0 + ai * HALF + (2 * mh + m2) * 16) * ldc + col0;
#pragma unroll
                    for (int bj = 0; bj < 2; ++bj)
#pragma unroll
                        for (int n = 0; n < 2; ++n) *(f32x4*)(out + off + bj * HALF + n * 16) = bs[m2][bj][n] + acc[ai][bj][2 * mh + m2][n]; }
            }
    }
};
struct EpiResidNorm {
    static constexpr bool PERM = false, AFTER_DRAIN = true;
    const float* base; float* out; int ldc; const float* w; bf16_t* xn; unsigned* xbuf; unsigned* cnt; int mode; float eps;
    __device__ __forceinline__ void fused(f32x4 (&acc)[2][2][4][2], const Unit& u, int wr, int wc, int fr, int fq, PG8_LAS unsigned char* lds, int wid, int lane) const {
        PG8_LAS float* P = (PG8_LAS float*)lds;
        PG8_LAS float* S = (PG8_LAS float*)(lds + 4096);
        int row0 = u.pm * BM + wr * 64 + fr, col0 = u.pn * BM + wc * 32 + 4 * fq;
        asm volatile("" : "+v"(row0), "+v"(col0));
#pragma unroll
        for (int ai = 0; ai < 2; ++ai)
#pragma unroll
            for (int m = 0; m < 4; ++m) {
                f32x4 bs[2][2]; const unsigned off = (unsigned)(row0 + ai * HALF + m * 16) * (unsigned)ldc + (unsigned)col0;
#pragma unroll
                for (int bj = 0; bj < 2; ++bj)
#pragma unroll
                    for (int n = 0; n < 2; ++n) bs[bj][n] = *(const f32x4*)(base + off + bj * HALF + n * 16);
#pragma unroll
                for (int bj = 0; bj < 2; ++bj)
#pragma unroll
                    for (int n = 0; n < 2; ++n) acc[ai][bj][m][n] += bs[bj][n];
                asm volatile("" : "+v"(acc[ai][0][m][0]), "+v"(acc[ai][0][m][1]), "+v"(acc[ai][1][m][0]), "+v"(acc[ai][1][m][1]) :: "memory");
            }
#pragma unroll
        for (int ai = 0; ai < 2; ++ai)
#pragma unroll
            for (int m = 0; m < 4; ++m) { float sq = 0.f;
#pragma unroll
                for (int bj = 0; bj < 2; ++bj)
#pragma unroll
                    for (int n = 0; n < 2; ++n) { const f32x4 x = acc[ai][bj][m][n]; sq += (x[0] * x[0] + x[1] * x[1]) + (x[2] * x[2] + x[3] * x[3]); }
                sq += __shfl_xor(sq, 16); sq += __shfl_xor(sq, 32);
                if (fq == 0) P[(ai * HALF + wr * 64 + m * 16 + fr) * 4 + wc] = sq; }
        asm volatile("s_waitcnt lgkmcnt(0)" ::: "memory"); __builtin_amdgcn_s_barrier(); asm volatile("" ::: "memory");
        const int row = wid * 32 + (lane & 31);
        if (lane < 32) { const float t = (P[row * 4 + 0] + P[row * 4 + 1]) + (P[row * 4 + 2] + P[row * 4 + 3]);
            __hip_atomic_store(xbuf + ((unsigned)(u.pm * BM + row) * 4u + (unsigned)u.pn), __float_as_uint(t), __ATOMIC_RELAXED, __HIP_MEMORY_SCOPE_AGENT); }
        asm volatile("s_waitcnt vmcnt(0)" ::: "memory");
        if (lane == 0) __hip_atomic_fetch_add(cnt + 64 * u.pm, 1u, __ATOMIC_RELAXED, __HIP_MEMORY_SCOPE_AGENT);
        if (wid == 0) { unsigned sp = 0u;
            while ((unsigned)__builtin_amdgcn_readfirstlane(__hip_atomic_load(cnt + 64 * u.pm, __ATOMIC_RELAXED, __HIP_MEMORY_SCOPE_AGENT)) < 32u) { __builtin_amdgcn_s_sleep(2); if (++sp > (1u << 22)) break; }
            __builtin_amdgcn_fence(__ATOMIC_ACQUIRE, "agent"); }
        asm volatile("s_waitcnt vmcnt(0) lgkmcnt(0)" ::: "memory"); __builtin_amdgcn_s_barrier(); asm volatile("" ::: "memory");
        if (lane < 32) { const unsigned* sl = xbuf + (unsigned)(u.pm * BM + row) * 4u; float t = 0.f;
#pragma unroll
            for (int k = 0; k < 4; ++k) t += __uint_as_float(__hip_atomic_load(sl + k, __ATOMIC_RELAXED, __HIP_MEMORY_SCOPE_AGENT));
            S[row] = __builtin_amdgcn_rsqf(t * (1.0f / 1024.0f) + eps); }
        asm volatile("s_waitcnt lgkmcnt(0)" ::: "memory"); __builtin_amdgcn_s_barrier(); asm volatile("" ::: "memory");
        f32x4 wv[2][2];
#pragma unroll
        for (int bj = 0; bj < 2; ++bj)
#pragma unroll
            for (int n = 0; n < 2; ++n) wv[bj][n] = *(const f32x4*)(w + col0 + bj * HALF + n * 16);
#pragma unroll
        for (int ai = 0; ai < 2; ++ai)
#pragma unroll
            for (int m = 0; m < 4; ++m) { const int r = ai * HALF + wr * 64 + m * 16 + fr; const float rs = S[r]; const unsigned off = (unsigned)(u.pm * BM + r) * (unsigned)ldc + (unsigned)col0;
#pragma unroll
                for (int bj = 0; bj < 2; ++bj)
#pragma unroll
                    for (int n = 0; n < 2; ++n) { const f32x4 x = acc[ai][bj][m][n]; const f32x4 y = x * rs * wv[bj][n];
                        if (mode == 1) *(f32x4*)(out + off + bj * HALF + n * 16) = y;
                        else { *(f32x4*)(out + off + bj * HALF + n * 16) = x;
                            typedef unsigned u32x2v __attribute__((ext_vector_type(2))); u32x2v pkd; pkd.x = cvt_pk_bf16(y[0], y[1]); pkd.y = cvt_pk_bf16(y[2], y[3]);
                            *(u32x2v*)(xn + off + bj * HALF + n * 16) = pkd; } } }
    }
};

template <class Epi, class Sched, bool ALIGN_EPI = false, bool SP2 = false>
__device__ __forceinline__ void gemm_phase(PG8_LAS unsigned char* lds, const Gemm g, const Sched& S, const Epi& E) {
    int tid_ = threadIdx.x; asm volatile("" : "+v"(tid_));
    const int tid = tid_, wid = __builtin_amdgcn_readfirstlane(tid >> 6), lane = tid & 63, wr = wid >> 2, wc = wid & 3, fr = lane & 15, fq = lane >> 4;
    const int lda = g.lda, ldb = g.ldb;
    unsigned voffA[2], voffB[2];
#pragma unroll
    for (int i = 0; i < 2; ++i) { int R, C; stage_rc(tid * 16 + i * 8192, R, C); const int Rb = Epi::PERM ? ((R & ~31) + perm32(R & 31)) : R;
        voffA[i] = (unsigned)(R * lda + C) * 2u; voffB[i] = (unsigned)(Rb * ldb + C) * 2u; }
    const size_t kstep = (size_t)(BK * 2);
    const size_t hstepA = (size_t)HALF * lda * 2, hstepB = (size_t)HALF * ldb * 2;
    const size_t tstepA = 2 * hstepA, tstepB = 2 * hstepB;
    const unsigned ldsw = (unsigned)wid * 1024u;
    const int aoff = lds_byte(wr * 64 + fr, fq * 8), boff = lds_byte(wc * 32 + fr, fq * 8);
#define PG8_SA(b, h) (((b) * 2 + (h)) * HTB)
#define PG8_SB(b, h) ((4 + (b) * 2 + (h)) * HTB)
#define PG8_STAGE(bufoff, gbase, voff) do { _Pragma("unroll") for (int _i = 0; _i < 2; ++_i) \
        __builtin_amdgcn_global_load_lds((const unsigned*)((const char*)(gbase) + (voff)[_i]), (PG8_LAS unsigned*)(lds + (bufoff) + ldsw + _i * 8192), 16, 0, 0); } while (0)
#define PG8_LDA(dst, b, h) do { _Pragma("unroll") for (int m = 0; m < 4; ++m) _Pragma("unroll") for (int k = 0; k < 2; ++k) dst[m][k] = *(const PG8_LAS bf16x8*)(lds + PG8_SA(b, h) + aoff + m * 2048 + k * 1024); } while (0)
#define PG8_LDB(dst, b, h) do { _Pragma("unroll") for (int n = 0; n < 2; ++n) _Pragma("unroll") for (int k = 0; k < 2; ++k) dst[n][k] = *(const PG8_LAS bf16x8*)(lds + PG8_SB(b, h) + boff + n * 2048 + k * 1024); } while (0)
#define PG8_MMA(ai, bj, At, Bt) do { __builtin_amdgcn_s_setprio(1); _Pragma("unroll") for (int m = 0; m < 4; ++m) _Pragma("unroll") for (int n = 0; n < 2; ++n) _Pragma("unroll") for (int k = 0; k < 2; ++k) \
        acc[ai][bj][m][n] = __builtin_amdgcn_mfma_f32_16x16x32_bf16(Bt[n][k], At[m][k], acc[ai][bj][m][n], 0, 0, 0); __builtin_amdgcn_s_setprio(0); } while (0)
#define PG8_WAIT_V(n) asm volatile("s_waitcnt vmcnt(" #n ")" ::: "memory")
#define PG8_WAIT_L(n) asm volatile("s_waitcnt lgkmcnt(" #n ")" ::: "memory")
#define PG8_BAR __builtin_amdgcn_s_barrier()
#define PG8_SCHED __builtin_amdgcn_sched_barrier(0)
    Unit cur, nxt; int ui = 0;
    if (!S.next(0, cur)) return;
    f32x4 acc[2][2][4][2];
#pragma unroll
    for (int a = 0; a < 2; ++a)
#pragma unroll
        for (int b = 0; b < 2; ++b)
#pragma unroll
            for (int m = 0; m < 4; ++m)
#pragma unroll
                for (int n = 0; n < 2; ++n) acc[a][b][m][n] = (f32x4){0.f, 0.f, 0.f, 0.f};
    bf16x8 At[4][2], B0[2][2], B1[2][2];
    const char* cA = (const char*)g.A + (size_t)cur.pm * tstepA + cur.ka; const char* cB = (const char*)g.Bt + (size_t)cur.pn * tstepB + cur.kb;
    S.a_ready(cur);
    if constexpr (SP2) {
        PG8_STAGE(PG8_SB(0, 0), cB, voffB); PG8_STAGE(PG8_SB(0, 1), cB + hstepB, voffB); PG8_STAGE(PG8_SA(0, 0), cA, voffA); PG8_STAGE(PG8_SA(0, 1), cA + hstepA, voffA);
        if (wr == 1) PG8_BAR;
        PG8_WAIT_V(2); PG8_BAR;
        PG8_STAGE(PG8_SB(1, 0), cB + kstep, voffB); PG8_STAGE(PG8_SA(1, 0), cA + kstep, voffA); PG8_STAGE(PG8_SB(1, 1), cB + hstepB + kstep, voffB);
        PG8_WAIT_V(6); PG8_BAR;
    } else {
        PG8_STAGE(PG8_SB(0, 0), cB, voffB); PG8_STAGE(PG8_SA(0, 0), cA, voffA); PG8_STAGE(PG8_SB(0, 1), cB + hstepB, voffB); PG8_STAGE(PG8_SA(0, 1), cA + hstepA, voffA);
        if (wr == 1) PG8_BAR;
        PG8_WAIT_V(4); PG8_BAR;
        PG8_STAGE(PG8_SB(1, 0), cB + kstep, voffB); PG8_STAGE(PG8_SA(1, 0), cA + kstep, voffA); PG8_STAGE(PG8_SB(1, 1), cB + hstepB + kstep, voffB);
        PG8_WAIT_V(6); PG8_BAR;
    }
    for (;;) {
        const bool has_next = S.next(ui + 1, nxt);
        const char* nA = has_next ? (const char*)g.A + (size_t)nxt.pm * tstepA + nxt.ka : cA; const char* nB = has_next ? (const char*)g.Bt + (size_t)nxt.pn * tstepB + nxt.kb : cB;
        const int nt = cur.nt;
        for (int t = 0; t < nt; t += 2) {
            const bool last = (t == nt - 2);
            const char* a1 = cA + (size_t)(t + 1) * kstep;
            const char* a2 = last ? nA : cA + (size_t)(t + 2) * kstep; const char* b2 = last ? nB : cB + (size_t)(t + 2) * kstep;
            const char* a3 = a2 + kstep; const char* b3 = b2 + kstep;
            if (last && has_next) S.a_ready(nxt);
            if constexpr (SP2) {
            PG8_LDB(B0, 0, 0); PG8_LDB(B1, 0, 1); PG8_SCHED; PG8_LDA(At, 0, 0); PG8_STAGE(PG8_SA(1, 1), a1 + hstepA, voffA);
            PG8_WAIT_V(8); PG8_WAIT_L(0); PG8_BAR; PG8_MMA(0, 0, At, B0); PG8_MMA(0, 1, At, B1); PG8_BAR; PG8_SCHED;
            PG8_LDA(At, 0, 1); PG8_STAGE(PG8_SB(0, 0), b2, voffB); PG8_STAGE(PG8_SB(0, 1), b2 + hstepB, voffB); PG8_STAGE(PG8_SA(0, 0), a2, voffA);
            PG8_WAIT_V(8); PG8_WAIT_L(0); PG8_BAR; PG8_MMA(1, 0, At, B0); PG8_MMA(1, 1, At, B1); PG8_BAR; PG8_SCHED;
            PG8_LDB(B0, 1, 0); PG8_LDB(B1, 1, 1); PG8_SCHED; PG8_LDA(At, 1, 0); PG8_STAGE(PG8_SA(0, 1), a2 + hstepA, voffA);
            PG8_WAIT_V(8); PG8_WAIT_L(0); PG8_BAR; PG8_MMA(0, 0, At, B0); PG8_MMA(0, 1, At, B1); PG8_BAR; PG8_SCHED;
            PG8_LDA(At, 1, 1); PG8_STAGE(PG8_SB(1, 0), b3, voffB); PG8_STAGE(PG8_SB(1, 1), b3 + hstepB, voffB); PG8_STAGE(PG8_SA(1, 0), a3, voffA);
            PG8_WAIT_V(8); PG8_WAIT_L(0); PG8_BAR; PG8_MMA(1, 0, At, B0); PG8_MMA(1, 1, At, B1); PG8_BAR; PG8_SCHED;
            } else {
            PG8_LDB(B0, 0, 0); PG8_SCHED; PG8_LDA(At, 0, 0); PG8_STAGE(PG8_SA(1, 1), a1 + hstepA, voffA);
            PG8_WAIT_L(8); PG8_BAR; PG8_WAIT_L(0); PG8_MMA(0, 0, At, B0); PG8_BAR; PG8_SCHED;
            PG8_LDB(B1, 0, 1); PG8_STAGE(PG8_SB(0, 0), b2, voffB);
            PG8_BAR; PG8_WAIT_L(0); PG8_MMA(0, 1, At, B1); PG8_BAR;
            PG8_LDA(At, 0, 1); PG8_STAGE(PG8_SA(0, 0), a2, voffA);
            PG8_BAR; PG8_WAIT_L(0); PG8_MMA(1, 0, At, B0); PG8_BAR; PG8_SCHED;
            PG8_STAGE(PG8_SB(0, 1), b2 + hstepB, voffB);
            PG8_WAIT_V(6); PG8_BAR; PG8_MMA(1, 1, At, B1); PG8_BAR;
            PG8_LDB(B0, 1, 0); PG8_SCHED; PG8_LDA(At, 1, 0); PG8_STAGE(PG8_SA(0, 1), a2 + hstepA, voffA);
            PG8_WAIT_L(8); PG8_BAR; PG8_WAIT_L(0); PG8_MMA(0, 0, At, B0); PG8_BAR; PG8_SCHED;
            PG8_LDB(B1, 1, 1); PG8_STAGE(PG8_SB(1, 0), b3, voffB);
            PG8_BAR; PG8_WAIT_L(0); PG8_MMA(0, 1, At, B1); PG8_BAR;
            PG8_LDA(At, 1, 1); PG8_STAGE(PG8_SA(1, 0), a3, voffA);
            PG8_BAR; PG8_WAIT_L(0); PG8_MMA(1, 0, At, B0); PG8_BAR; PG8_SCHED;
            PG8_STAGE(PG8_SB(1, 1), b3 + hstepB, voffB);
            PG8_WAIT_V(6); PG8_BAR; PG8_MMA(1, 1, At, B1); PG8_BAR;
            }
        }
        if constexpr (ALIGN_EPI) { if (wr == 0) PG8_BAR; }
        if constexpr (!Epi::AFTER_DRAIN) { E(acc, cur, wr, wc, fr, fq); S.done(cur); }
        if (!has_next) break;
#pragma unroll
        for (int a = 0; a < 2; ++a)
#pragma unroll
            for (int b = 0; b < 2; ++b)
#pragma unroll
                for (int m = 0; m < 4; ++m)
#pragma unroll
                    for (int n = 0; n < 2; ++n) acc[a][b][m][n] = (f32x4){0.f, 0.f, 0.f, 0.f};
        cur = nxt; cA = nA; cB = nB; ++ui;
        if constexpr (ALIGN_EPI) { if (wr == 1) PG8_BAR; }
    }
    PG8_WAIT_V(0);
    if constexpr (!ALIGN_EPI) { if (wr == 0) PG8_BAR; }
    PG8_BAR;
    if constexpr (Epi::AFTER_DRAIN) { E.fused(acc, cur, wr, wc, fr, fq, lds, wid, lane); S.done(cur); }
#undef PG8_SA
#undef PG8_SB
#undef PG8_STAGE
#undef PG8_LDA
#undef PG8_LDB
#undef PG8_MMA
#undef PG8_WAIT_V
#undef PG8_WAIT_L
#undef PG8_BAR
#undef PG8_SCHED
}
}

constexpr int NWAVES = 8, NTHR = 512;
constexpr int BATCH = 4, T = 4096, D = 1024, M = BATCH * T, DEPTH = 2;
constexpr int N_IN = 9232;
constexpr float EPS = 1e-6f;
constexpr int PJ = 6144;
constexpr int C_SX = 0, C_SB = 1024, C_SC = 1280, C_MX = 1536, C_MO = 2048, C_GQ = 2560, C_GF = 3072, C_GI = 3584, C_SZ = 4096, C_MZ = 5120, C_GZ = 5632;
constexpr int HALO_COLS = 1536;
constexpr int O_SX = 0, O_SB = 1024, O_SC = 1280, O_DT = 1536, O_SZ = 1552, O_MX = 2576, O_MO = 3088, O_MZ = 3600, O_GQ = 4112, O_GF = 4624, O_GI = 5136, O_GZ = 5648, O_GATE = 6160;
__host__ __device__ __forceinline__ int orig_col(int n) {
    if (n < 1536) return n;
    if (n < 2048) return O_MX + (n - 1536);
    if (n < 2560) return O_MO + (n - 2048);
    if (n < 3072) return O_GQ + (n - 2560);
    if (n < 3584) return O_GF + (n - 3072);
    if (n < 4096) return O_GI + (n - 3584);
    if (n < 5120) return O_SZ + (n - 4096);
    if (n < 5632) return O_MZ + (n - 5120);
    return O_GZ + (n - 5632);
}
constexpr size_t MiB = 1u << 20;
constexpr size_t WS_CTL = 0, CTL_ZERO_BYTES = 64 * 1024;
constexpr size_t WS_W1 = 1 * MiB;
constexpr size_t WS_W2 = 13 * MiB;
constexpr size_t WS_WBR = 19 * MiB;
constexpr size_t WS_WOUT = 23 * MiB;
constexpr size_t WS_WDT = 25 * MiB;
constexpr size_t WS_WQKV = 25 * MiB + 64 * 1024;
constexpr size_t WS_HALO = 26 * MiB;
constexpr size_t WS_XBUF = 28 * MiB + 512 * 1024;
constexpr size_t WS_SC64A = 64 * 1024;
constexpr size_t WS_SC64B = 25 * MiB + 512 * 1024;
constexpr size_t WS_MLC = 64 * 1024 + 512 * 1024;
constexpr size_t WS_MLP = 28 * MiB + 256 * 1024;
constexpr size_t WS_DT = 29 * MiB;
constexpr size_t WS_IF = 30 * MiB;
constexpr size_t WS_HGV = 30 * MiB + 512 * 1024;
constexpr size_t WS_XN = 32 * MiB;
constexpr size_t WS_SCR = 64 * MiB;
constexpr size_t WS_PROJ = 96 * MiB;
constexpr size_t WS_END = 288 * MiB;
constexpr int CW_PANEL = 8192;
constexpr int CW_BAR = 1024;

constexpr int LDS_BYTES = 163840;
constexpr int MISC_OFF = 159744;

#define GAS __attribute__((address_space(1)))
#define LAS __attribute__((address_space(3)))
typedef unsigned short bf16;
typedef unsigned v4u __attribute__((ext_vector_type(4)));
typedef unsigned v2u __attribute__((ext_vector_type(2)));
typedef float f32x4 __attribute__((ext_vector_type(4)));
#define LDS_WAIT() asm volatile("s_waitcnt lgkmcnt(0)" ::: "memory")
#define LDS_BARRIER() do { asm volatile("s_waitcnt lgkmcnt(0)" ::: "memory"); __builtin_amdgcn_s_barrier(); asm volatile("" ::: "memory"); } while (0)
#define VM_WAIT() asm volatile("s_waitcnt vmcnt(0)" ::: "memory")
#define SCHED_FENCE() __builtin_amdgcn_sched_barrier(0)
typedef __bf16 hbf16x2 __attribute__((ext_vector_type(2)));
typedef float hf32x2 __attribute__((ext_vector_type(2)));
__device__ __forceinline__ unsigned pk2(float lo, float hi) { const hf32x2 v = {lo, hi}; return __builtin_bit_cast(unsigned, __builtin_convertvector(v, hbf16x2)); }
__device__ __forceinline__ unsigned f2bf(float f) { return pk2(f, 0.f) & 0xffffu; }
__device__ __forceinline__ float bf2f(unsigned short h) { return __uint_as_float((unsigned)h << 16); }
__device__ __forceinline__ float blo(unsigned w) { return __uint_as_float(w << 16); }
__device__ __forceinline__ float bhi(unsigned w) { return __uint_as_float(w & 0xffff0000u); }
__device__ __forceinline__ void unpack8(const v4u w, float (&f)[8]) { f[0] = blo(w.x); f[1] = bhi(w.x); f[2] = blo(w.y); f[3] = bhi(w.y); f[4] = blo(w.z); f[5] = bhi(w.z); f[6] = blo(w.w); f[7] = bhi(w.w); }
__device__ __forceinline__ v4u pack8(const float (&f)[8]) { v4u w; w.x = pk2(f[0], f[1]); w.y = pk2(f[2], f[3]); w.z = pk2(f[4], f[5]); w.w = pk2(f[6], f[7]); return w; }
__device__ __forceinline__ float sigm(float x) { return __builtin_amdgcn_rcpf(1.0f + __expf(-x)); }
__device__ __forceinline__ float siluf(float x) { return x * __builtin_amdgcn_rcpf(1.0f + __expf(-x)); }
__device__ __forceinline__ float softplusf(float x) { return x > 20.f ? x : log1pf(__expf(x)); }
__device__ __forceinline__ float logsigmoidf(float x) { return x < 0.f ? x - log1pf(__expf(x)) : -log1pf(__expf(-x)); }
__device__ __forceinline__ float wave_sum(float v) {
#pragma unroll
    for (int o = 1; o < 64; o <<= 1) v += __shfl_xor(v, o);
    return v;
}

#define XB_TMO      128
#define XB_XCNT(j)  (256  + 64 * (j))
#define XB_XSUB(j)  (1280 + 64 * (j))
#define XB_XGEN(j)  (2304 + 64 * (j))
#define XB_TOP      3328
#define XB_TOPGEN   3392
#define XCD_BAR_WORDS 3456
#define XB_SPIN_CAP (1u << 20)
__device__ __forceinline__ unsigned xb_ld(unsigned* p)              { return __hip_atomic_load(p, __ATOMIC_RELAXED, __HIP_MEMORY_SCOPE_AGENT); }
__device__ __forceinline__ unsigned xb_add(unsigned* p, unsigned v) { return __hip_atomic_fetch_add(p, v, __ATOMIC_RELAXED, __HIP_MEMORY_SCOPE_AGENT); }
__device__ __forceinline__ unsigned xb_xcc_id() { return (unsigned)__builtin_amdgcn_s_getreg((3 << 11) | 20) & 0xFu; }
#define XB_SPIN(cond, bar) do { unsigned _sp = 0; while (cond) { __builtin_amdgcn_s_sleep(1); \
    if ((++_sp & 255u) == 0u) { if (xb_ld(&(bar)[XB_TMO])) break; if (_sp > XB_SPIN_CAP) { atomicAdd(&(bar)[XB_TMO], 1u); break; } } } } while (0)
struct XcdBarrier { unsigned* bar; unsigned x; volatile LAS unsigned* st; };
__device__ __forceinline__ XcdBarrier xcd_barrier_post(unsigned* bar, volatile LAS unsigned* st) {
    XcdBarrier b; b.bar = bar; b.x = xb_xcc_id(); b.st = st;
    if (threadIdx.x == 0) (void)xb_add(&bar[XB_XCNT(b.x)], 1u);
    return b;
}
__device__ __forceinline__ void xcd_barrier_complete(unsigned* bar, unsigned x, unsigned& nloc, unsigned& nx) {
    const unsigned G = gridDim.x * gridDim.y * gridDim.z;
    unsigned sum, cnt, mine, sp = 0u;
    for (;;) {
        sum = 0u; cnt = 0u; mine = 0u;
#pragma unroll
        for (unsigned j = 0; j < 16; ++j) { const unsigned c = xb_ld(&bar[XB_XCNT(j)]); sum += c; cnt += (c > 0u) ? 1u : 0u; mine = (j == x) ? c : mine; }
        if (sum == G) break;
        __builtin_amdgcn_s_sleep(1);
        if ((++sp & 255u) == 0u) { if (xb_ld(&bar[XB_TMO])) break; if (sp > XB_SPIN_CAP) { atomicAdd(&bar[XB_TMO], 1u); break; } }
    }
    nloc = mine > 0u ? mine : 1u; nx = cnt > 0u ? cnt : 1u;
}
__device__ __forceinline__ void xcd_barrier(const XcdBarrier& b) {
    asm volatile("s_waitcnt vmcnt(0)" ::: "memory");
    __syncthreads();
    if (threadIdx.x == 0) {
        unsigned long long pb_ = (unsigned long long)b.bar; asm volatile("" : "+v"(pb_));
        unsigned* bar = (unsigned*)pb_;
        __builtin_amdgcn_s_waitcnt(0);
        unsigned nloc = b.st[0], nx = b.st[1];
        if (nloc == 0u) { xcd_barrier_complete(bar, b.x, nloc, nx); b.st[0] = nloc; b.st[1] = nx; }
        const unsigned old = xb_add(&bar[XB_XSUB(b.x)], 1u);
        const unsigned gen = old / nloc;
        if (old + 1u == (gen + 1u) * nloc) {
            __builtin_amdgcn_fence(__ATOMIC_RELEASE, "agent");
            asm volatile("s_waitcnt vmcnt(0)" ::: "memory");
            const unsigned og = xb_add(&bar[XB_TOP], 1u);
            const unsigned tg = og / nx;
            if (og + 1u == (tg + 1u) * nx) xb_add(&bar[XB_TOPGEN], 1u);
            else XB_SPIN(xb_ld(&bar[XB_TOPGEN]) == tg, bar);
            __builtin_amdgcn_fence(__ATOMIC_ACQUIRE, "agent");
            xb_add(&bar[XB_XGEN(b.x)], 1u);
            asm volatile("s_waitcnt vmcnt(0)" ::: "memory");
        } else {
            XB_SPIN(xb_ld(&bar[XB_XGEN(b.x)]) == gen, bar);
            __builtin_amdgcn_fence(__ATOMIC_ACQUIRE, "agent");
            asm volatile("s_waitcnt vmcnt(0)" ::: "memory");
        }
    }
    __syncthreads();
}

struct Args { const float* in[25]; float* out; unsigned char* ws; int ph_lo, ph_hi; };
enum { I_X = 0, I_NORMW, I_WIN, I_SCW, I_SCB, I_DTB, I_ALOG, I_SD, I_SNW, I_MCW, I_MCB, I_WQ, I_WK, I_WV, I_WIF, I_BIF, I_MNW, I_MSKIP, I_HLB, I_HNW, I_WBS, I_WBM, I_WBH, I_WOUT, I_FNW };

__device__ __forceinline__ void transpose_item(const float* W, int ldw, int srcn0, int k0, bf16* WT, int ldt, int dstn0, int dstk0, LAS float* scr, int lane) {
#pragma unroll 8
    for (int i = 0; i < 32; ++i) { const int kk = 2 * i + (lane >> 5); scr[kk * 33 + (lane & 31)] = W[(size_t)(k0 + kk) * ldw + srcn0 + (lane & 31)]; }
    LDS_WAIT(); asm volatile("" ::: "memory");
    const int c = lane & 7;
#pragma unroll
    for (int j = 0; j < 4; ++j) { const int n = (lane >> 3) + 8 * j; const LAS float* s = scr + (8 * c) * 33 + n;
        v4u o; o.x = pk2(s[0 * 33], s[1 * 33]); o.y = pk2(s[2 * 33], s[3 * 33]); o.z = pk2(s[4 * 33], s[5 * 33]); o.w = pk2(s[6 * 33], s[7 * 33]);
        *(GAS v4u*)(WT + (size_t)(dstn0 + n) * ldt + dstk0 + k0 + 8 * c) = o; }
    LDS_WAIT(); asm volatile("" ::: "memory");
}
__device__ __forceinline__ void rms_row_to_bf16(const float* xrow, const float* w, bf16* orow, int lane) {
    const GAS f32x4* xr = (const GAS f32x4*)xrow + lane; const GAS f32x4* wr = (const GAS f32x4*)w + lane;
    f32x4 v[4]; float s = 0.f;
#pragma unroll
    for (int j = 0; j < 4; ++j) { v[j] = xr[64 * j]; s += (v[j].x * v[j].x + v[j].y * v[j].y) + (v[j].z * v[j].z + v[j].w * v[j].w); }
    const float rstd = 1.0f / sqrtf(wave_sum(s) * (1.f / D) + EPS);
    GAS v2u* o8 = (GAS v2u*)orow + lane;
#pragma unroll
    for (int j = 0; j < 4; ++j) { const f32x4 ww = wr[64 * j]; v2u o; o.x = pk2(v[j].x * rstd * ww.x, v[j].y * rstd * ww.y); o.y = pk2(v[j].z * rstd * ww.z, v[j].w * rstd * ww.w); o8[64 * j] = o; }
}
__device__ __forceinline__ void phase_norm(const float* X, const float* w, bf16* XN, int gw, int NGW, int lane) {
    const GAS f32x4* wr = (const GAS f32x4*)w + lane;
    f32x4 ww[4];
#pragma unroll
    for (int j = 0; j < 4; ++j) ww[j] = wr[64 * j];
    for (int m = gw; m < M; m += 4 * NGW) {
        f32x4 v[4][4];
#pragma unroll
        for (int u = 0; u < 4; ++u) { const int mm = (m + u * NGW < M) ? m + u * NGW : m; const GAS f32x4* xr = (const GAS f32x4*)(X + (size_t)mm * D) + lane;
#pragma unroll
            for (int j = 0; j < 4; ++j) v[u][j] = xr[64 * j]; }
#pragma unroll
        for (int u = 0; u < 4; ++u) { if (m + u * NGW < M) { float s0 = 0.f;
#pragma unroll
            for (int j = 0; j < 4; ++j) s0 += (v[u][j].x * v[u][j].x + v[u][j].y * v[u][j].y) + (v[u][j].z * v[u][j].z + v[u][j].w * v[u][j].w);
            const float r0 = __builtin_amdgcn_rsqf(wave_sum(s0) * (1.f / D) + EPS);
            GAS v2u* o0 = (GAS v2u*)(XN + (size_t)(m + u * NGW) * D) + lane;
#pragma unroll
            for (int j = 0; j < 4; ++j) { v2u o; o.x = pk2(v[u][j].x * r0 * ww[j].x, v[u][j].y * r0 * ww[j].y); o.y = pk2(v[u][j].z * r0 * ww[j].z, v[u][j].w * r0 * ww[j].w); o0[64 * j] = o; } } }
    }
}
__device__ __forceinline__ void phase_weights(const Args& a, unsigned char* ws, int l, LAS unsigned char* lds, int gw, int NGW, int wave, int lane) {
    LAS float* scr = (LAS float*)(lds + wave * 16384);
    const float* w_in = a.in[I_WIN] + (size_t)l * D * N_IN;
    bf16* W1 = (bf16*)(ws + WS_W1); bf16* W2 = (bf16*)(ws + WS_W2); bf16* WBR = (bf16*)(ws + WS_WBR); bf16* WOUT = (bf16*)(ws + WS_WOUT); bf16* WQKV = (bf16*)(ws + WS_WQKV); bf16* WDT = (bf16*)(ws + WS_WDT);
    constexpr int I_1 = 16 * (PJ / 32), I_2 = 16 * (3072 / 32), I_BS = 16 * 32, I_BM = 8 * 32, I_BH = 8 * 32, I_O = 16 * 32, I_QKV = 3 * 4 * 2 * 4;
    constexpr int NITEMS = I_1 + I_2 + I_BS + I_BM + I_BH + I_O + I_QKV;
    for (int it = gw; it < NITEMS; it += NGW) {
        int r = it;
        const float* src; int ldw, srcn0, k0, ldt, dstn0, dstk0; bf16* dst;
        if (r < I_1) { const int nb = r % (PJ / 32), kb = r / (PJ / 32); src = w_in; ldw = N_IN; srcn0 = orig_col(nb * 32); k0 = kb * 64; dst = W1; ldt = D; dstn0 = nb * 32; dstk0 = 0; }
        else if ((r -= I_1) < I_2) { const int nb = r % 96, kb = r / 96; src = w_in; ldw = N_IN; srcn0 = O_GATE + nb * 32; k0 = kb * 64; dst = W2; ldt = D; dstn0 = nb * 32; dstk0 = 0; }
        else if ((r -= I_2) < I_BS) { const int nb = r % 32, kb = r / 32; src = a.in[I_WBS] + (size_t)l * 1024 * 1024; ldw = 1024; srcn0 = nb * 32; k0 = kb * 64; dst = WBR; ldt = 2048; dstn0 = nb * 32; dstk0 = 0; }
        else if ((r -= I_BS) < I_BM) { const int nb = r % 32, kb = r / 32; src = a.in[I_WBM] + (size_t)l * 512 * 1024; ldw = 1024; srcn0 = nb * 32; k0 = kb * 64; dst = WBR; ldt = 2048; dstn0 = nb * 32; dstk0 = 1024; }
        else if ((r -= I_BM) < I_BH) { const int nb = r % 32, kb = r / 32; src = a.in[I_WBH] + (size_t)l * 512 * 1024; ldw = 1024; srcn0 = nb * 32; k0 = kb * 64; dst = WBR; ldt = 2048; dstn0 = nb * 32; dstk0 = 1536; }
        else if ((r -= I_BH) < I_O) { const int nb = r % 32, kb = r / 32; src = a.in[I_WOUT] + (size_t)l * 1024 * 1024; ldw = 1024; srcn0 = nb * 32; k0 = kb * 64; dst = WOUT; ldt = 1024; dstn0 = nb * 32; dstk0 = 0; }
        else { r -= I_O; const int nb = r % 4, kb = (r / 4) % 2, h = (r / 8) % 4, which = r / 32;
            src = (which == 0 ? a.in[I_WQ] : (which == 1 ? a.in[I_WK] : a.in[I_WV])) + ((size_t)l * 4 + h) * 128 * 128; ldw = 128; srcn0 = nb * 32; k0 = kb * 64;
            dst = WQKV + ((size_t)which * 4 + h) * 128 * 128; ldt = 128; dstn0 = nb * 32; dstk0 = 0; }
        transpose_item(src, ldw, srcn0, k0, dst, ldt, dstn0, dstk0, scr, lane);
    }
    for (int g2 = gw; g2 < 16 * D / 64; g2 += NGW) { const int i = g2 * 64 + lane, h = i >> 10, k = i & (D - 1); WDT[i] = (bf16)f2bf(w_in[(size_t)k * N_IN + O_DT + h]); }
}

__device__ __forceinline__ float hg_lower_bound(const float* hlb, int l, int c) {
    float mx = hlb[c];
#pragma unroll
    for (int d = 1; d < DEPTH; ++d) mx = fmaxf(mx, hlb[d * 512 + c]);
    float sum = 0.f, part = 0.f;
#pragma unroll
    for (int d = 0; d < DEPTH; ++d) { const float e = __expf(hlb[d * 512 + c] - mx); sum += e; if (d >= 1 && d <= l) part += e; }
    return part / sum;
}
typedef short s16x8 __attribute__((ext_vector_type(8)));
#define MFMA16(a_, b_, c_) __builtin_amdgcn_mfma_f32_16x16x32_bf16((a_), (b_), (c_), 0, 0, 0)
constexpr int MP = 520;
__device__ __forceinline__ void phase_c0(const Args& a, unsigned char* ws, int l, LAS unsigned char* lds, int tile, int tid) {
    bf16* PROJ = (bf16*)(ws + WS_PROJ); bf16* XNQK = (bf16*)(ws + WS_XN); const bf16* HALO = (const bf16*)(ws + WS_HALO);
    const bf16* WDT = (const bf16*)(ws + WS_WDT); const bf16* WQKV = (const bf16*)(ws + WS_WQKV);
    float* DT = (float*)(ws + WS_DT); float* IFB = (float*)(ws + WS_IF); bf16* SCRV = (bf16*)(ws + WS_SCR);
    const int t0 = tile * 64;
    const int lane = tid & 63, w = tid >> 6, q = lane >> 4, r = lane & 15;
    {
        const int tw = w & 3, kh = w >> 2;
        const bf16* xrow = XNQK + (size_t)(t0 + 16 * tw + r) * D + kh * 512 + 8 * q;
        const bf16* wrow = WDT + (size_t)r * D + kh * 512 + 8 * q;
        f32x4 d = (f32x4){0.f, 0.f, 0.f, 0.f};
#pragma unroll 8
        for (int ks = 0; ks < 16; ++ks) d = MFMA16(*(const GAS s16x8*)(xrow + 32 * ks), *(const GAS s16x8*)(wrow + 32 * ks), d);
        LAS float* dtp = (LAS float*)lds;
#pragma unroll
        for (int i = 0; i < 4; ++i) dtp[(kh * 64 + 16 * tw + 4 * q + i) * 16 + r] = d[i];
        __syncthreads();
        const float* dtb = a.in[I_DTB] + l * 16;
#pragma unroll
        for (int o = tid; o < 1024; o += NTHR) { const float dv_ = softplusf(dtp[o] + dtp[1024 + o] + dtb[o & 15]); DT[(size_t)t0 * 16 + o] = dv_; dtp[2048 + o] = dv_; }
        __syncthreads();
        { float* sc64 = (float*)(ws + ((t0 < M / 2) ? WS_SC64A : WS_SC64B)) + (size_t)(t0 % (M / 2)) * 16;
#pragma unroll
          for (int hh = 0; hh < 2; ++hh) { const int h = 2 * w + hh; const float aneg = -__expf(a.in[I_ALOG][l * 16 + h]);
              float inc = dtp[2048 + lane * 16 + h] * aneg;
#pragma unroll
              for (int o = 1; o < 64; o <<= 1) { const float t = __shfl_up(inc, o); if (lane >= o) inc += t; }
              sc64[lane * 16 + h] = inc; } }
    }
    if (!(C0SKIP & 2)) {
        const float* cw = a.in[I_SCW] + (size_t)l * 4 * 1536; const float* cb = a.in[I_SCB] + (size_t)l * 1536;
        const bool seq_start = (t0 % T) == 0;
        const int strip = tid >> 5;
#pragma unroll 1
        for (int batch = 0; batch < 6; ++batch) {
            const int col = (32 * batch + (tid & 31)) * 8;
            v4u raw[7];
#pragma unroll
            for (int j = 0; j < 7; ++j) { const int r = 4 * strip - 3 + j;
                if (r >= 0) raw[j] = *(const GAS v4u*)(PROJ + (size_t)(t0 + r) * PJ + col);
                else if (seq_start) raw[j] = (v4u){0u, 0u, 0u, 0u};
                else raw[j] = *(const GAS v4u*)(HALO + ((size_t)(tile - 1) * 3 + (r + 3)) * HALO_COLS + col); }
            f32x4 wq[4][2], bq[2];
#pragma unroll
            for (int j = 0; j < 4; ++j) { wq[j][0] = *(const GAS f32x4*)(cw + j * 1536 + col); wq[j][1] = *(const GAS f32x4*)(cw + j * 1536 + col + 4); }
            bq[0] = *(const GAS f32x4*)(cb + col); bq[1] = *(const GAS f32x4*)(cb + col + 4);
            VM_WAIT(); __syncthreads();
            v4u outw[4];
#pragma unroll
            for (int wd = 0; wd < 4; ++wd) {
                float xl[7], xh[7];
#pragma unroll
                for (int j = 0; j < 7; ++j) { const unsigned u = raw[j][wd]; xl[j] = blo(u); xh[j] = bhi(u); }
                typedef float f32x2 __attribute__((ext_vector_type(2)));
                f32x2 wj[4];
#pragma unroll
                for (int j = 0; j < 4; ++j) { wj[j].x = wq[j][wd >> 1][2 * (wd & 1)]; wj[j].y = wq[j][wd >> 1][2 * (wd & 1) + 1]; }
                f32x2 bj; bj.x = bq[wd >> 1][2 * (wd & 1)]; bj.y = bq[wd >> 1][2 * (wd & 1) + 1];
#pragma unroll
                for (int rr = 0; rr < 4; ++rr) { float sl = bj.x, sh = bj.y;
#pragma unroll
                    for (int j = 0; j < 4; ++j) { sl += wj[j].x * xl[rr + j]; sh += wj[j].y * xh[rr + j]; }
                    outw[rr][wd] = pk2(siluf(sl), siluf(sh)); }
            }
#pragma unroll
            for (int rr = 0; rr < 4; ++rr) *(GAS v4u*)(PROJ + (size_t)(t0 + 4 * strip + rr) * PJ + col) = outw[rr];
        }
    }
    __syncthreads();
    {
        LAS bf16* mxs = (LAS bf16*)lds;
        LAS bf16* mcs = (LAS bf16*)(lds + 69680);
        LAS float* gp = (LAS float*)lds;
        const float* mcw = a.in[I_MCW] + (size_t)l * 4 * 512; const float* mcb = a.in[I_MCB] + (size_t)l * 512;
        const float* wif = a.in[I_WIF] + (size_t)l * 1536 * 8; const float* bif = a.in[I_BIF] + (size_t)l * 8;
        const bool sst = (t0 % T) == 0;
        for (int idx = tid; idx < 67 * 64; idx += NTHR) { const int rr = idx >> 6, ch = idx & 63;
            v4u v = (v4u){0u, 0u, 0u, 0u};
            if (!(sst && rr < 3)) v = *(const GAS v4u*)(PROJ + (size_t)(t0 - 3 + rr) * PJ + C_MX + ch * 8);
            *(LAS v4u*)(mxs + rr * MP + ch * 8) = v; }
        __syncthreads();
        { const int c = tid; const float w0 = mcw[c], w1 = mcw[512 + c], w2 = mcw[1024 + c], w3 = mcw[1536 + c], b0 = mcb[c];
          float x0 = bf2f(mxs[c]), x1 = bf2f(mxs[MP + c]), x2 = bf2f(mxs[2 * MP + c]);
#pragma unroll 8
          for (int tt = 0; tt < 64; ++tt) { const float x3 = bf2f(mxs[(tt + 3) * MP + c]); const float sacc = b0 + w0 * x0 + w1 * x1 + w2 * x2 + w3 * x3;
              mcs[tt * MP + c] = (bf16)f2bf(siluf(sacc)); x0 = x1; x1 = x2; x2 = x3; } }
        __syncthreads();
        float g[4][8];
#pragma unroll
        for (int tt = 0; tt < 4; ++tt)
#pragma unroll
            for (int j = 0; j < 8; ++j) g[tt][j] = 0.f;
        const int e0 = 16 * w;
        s16x8 afn[4];
#define C0_WLOAD(cmb) do { const bf16* wb_ = WQKV + ((size_t)(cmb) * 128 + e0 + r) * 128 + 8 * q; \
            _Pragma("unroll") for (int ks = 0; ks < 4; ++ks) afn[ks] = *(const GAS s16x8*)(wb_ + 32 * ks); } while (0)
        C0_WLOAD(0);
#pragma unroll 1
        for (int combo = 0; combo < 12; ++combo) {
            const int which = combo >> 2, h = combo & 3;
            s16x8 af[4];
#pragma unroll
            for (int ks = 0; ks < 4; ++ks) af[ks] = afn[ks];
            if (combo + 1 < 12) C0_WLOAD(combo + 1);
            f32x4 wi[4][2];
#pragma unroll
            for (int i = 0; i < 4; ++i) { const float* p = wif + (size_t)(h * 384 + which * 128 + e0 + 4 * q + i) * 8; wi[i][0] = *(const GAS f32x4*)p; wi[i][1] = *(const GAS f32x4*)(p + 4); }
            const LAS bf16* src = (which == 2) ? (mxs + 3 * MP) : mcs;
#pragma unroll
            for (int tt = 0; tt < 4; ++tt) { f32x4 d = (f32x4){0.f, 0.f, 0.f, 0.f};
#pragma unroll
                for (int ks = 0; ks < 4; ++ks) d = MFMA16(af[ks], *(const LAS s16x8*)(src + (16 * tt + r) * MP + h * 128 + 32 * ks + 8 * q), d);
                { v2u o; o.x = pk2(d[0], d[1]); o.y = pk2(d[2], d[3]);
                  bf16* dstp = (which < 2) ? (XNQK + (size_t)(t0 + 16 * tt + r) * 1024 + which * 512) : (SCRV + (size_t)(t0 + 16 * tt + r) * 1024 + 512);
                  *(GAS v2u*)(dstp + h * 128 + e0 + 4 * q) = o; }
#pragma unroll
                for (int i = 0; i < 4; ++i) { g[tt][0] += d[i] * wi[i][0].x; g[tt][1] += d[i] * wi[i][0].y; g[tt][2] += d[i] * wi[i][0].z; g[tt][3] += d[i] * wi[i][0].w;
                    g[tt][4] += d[i] * wi[i][1].x; g[tt][5] += d[i] * wi[i][1].y; g[tt][6] += d[i] * wi[i][1].z; g[tt][7] += d[i] * wi[i][1].w; } }
        }
#pragma unroll
        for (int tt = 0; tt < 4; ++tt)
#pragma unroll
            for (int j = 0; j < 8; ++j) { g[tt][j] += __shfl_xor(g[tt][j], 16); g[tt][j] += __shfl_xor(g[tt][j], 32); }
        __syncthreads();
        if (q == 0) {
#pragma unroll
            for (int tt = 0; tt < 4; ++tt) { *(LAS f32x4*)(gp + (w * 64 + 16 * tt + r) * 8) = (f32x4){g[tt][0], g[tt][1], g[tt][2], g[tt][3]}; *(LAS f32x4*)(gp + (w * 64 + 16 * tt + r) * 8 + 4) = (f32x4){g[tt][4], g[tt][5], g[tt][6], g[tt][7]}; } }
        __syncthreads();
        { const int t = tid >> 3, j = tid & 7; float sacc = bif[j];
#pragma unroll
          for (int ww = 0; ww < 8; ++ww) sacc += gp[(ww * 64 + t) * 8 + j];
          const float gv_ = (j < 4) ? sacc : logsigmoidf(sacc);
          IFB[(size_t)(t0 + t) * 8 + j] = gv_; gp[4096 + t * 8 + j] = gv_; }
        __syncthreads();
        if (w < 4) {
            float* mlc = (float*)(ws + WS_MLC); float* mlp = (float*)(ws + WS_MLP);
            const float li_ = gp[4096 + lane * 8 + w]; float inc = gp[4096 + lane * 8 + 4 + w];
#pragma unroll
            for (int o = 1; o < 64; o <<= 1) { const float t = __shfl_up(inc, o); if (lane >= o) inc += t; }
            float pm = li_ - inc;
#pragma unroll
            for (int o = 1; o < 64; o <<= 1) { const float t = __shfl_up(pm, o); if (lane >= o) pm = fmaxf(pm, t); }
            mlc[(size_t)(t0 + lane) * 4 + w] = inc; mlp[(size_t)(t0 + lane) * 4 + w] = pm;
        }
        __syncthreads();
    }
    {
        LAS bf16* FT = (LAS bf16*)lds;
        LAS bf16* QT = (LAS bf16*)(lds + 17408);
        LAS float* psum = (LAS float*)(lds + 34816);
        float* HGV = (float*)(ws + WS_HGV);
        constexpr int HP = 136;
        const int k = tid & 127, tq = tid >> 7;
#pragma unroll 1
        for (int h = 0; h < 4; ++h) {
#pragma unroll
            for (int i = 0; i < 2; ++i) { const int idx = tid + NTHR * i, row = idx >> 4, ch = idx & 15;
                *(LAS v4u*)(FT + row * HP + ch * 8) = *(const GAS v4u*)(PROJ + (size_t)(t0 + row) * PJ + C_GF + h * 128 + ch * 8);
                *(LAS v4u*)(QT + row * HP + ch * 8) = *(const GAS v4u*)(PROJ + (size_t)(t0 + row) * PJ + C_GQ + h * 128 + ch * 8); }
            __syncthreads();
            const float lb = hg_lower_bound(a.in[I_HLB], l, h * 128 + k), omlb = 1.f - lb;
            float cum[16], kk[16], qq[16]; float run = 0.f;
#pragma unroll
            for (int j = 0; j < 16; ++j) { const int t = 16 * tq + j; const float sg = sigm(bf2f(FT[t * HP + k])); const float f = lb + omlb * sg; run += __logf(f); cum[j] = run; kk[j] = omlb * (1.f - sg); qq[j] = siluf(bf2f(QT[t * HP + k])); }
            psum[tq * 128 + k] = run;
            __syncthreads();
            { const float p0 = psum[k], p1 = psum[128 + k], p2 = psum[256 + k], p3 = psum[384 + k];
              const float cmid = p0 + p1, cend = cmid + p2 + p3;
              const float off = (tq == 0) ? 0.f : (tq == 1 ? p0 : (tq == 2 ? cmid : cmid + p2));
              if (tq == 0) { float* hv = HGV + ((size_t)tile * 4 + h) * 384; hv[k] = __expf(cmid); hv[128 + k] = __expf(cend - cmid); hv[256 + k] = __expf(cend); }
#pragma unroll
              for (int j = 0; j < 16; ++j) { const float cj = off + cum[j]; const float em = __expf(fminf(fmaxf(cj - cmid, -80.f), 80.f)), rem = __builtin_amdgcn_rcpf(em); const int t = 16 * tq + j;
                  QT[t * HP + k] = (bf16)f2bf(qq[j] * em); FT[t * HP + k] = (bf16)f2bf(kk[j] * rem); } }
            __syncthreads();
#pragma unroll
            for (int i = 0; i < 2; ++i) { const int idx = tid + NTHR * i, row = idx >> 4, ch = idx & 15;
                *(GAS v4u*)(PROJ + (size_t)(t0 + row) * PJ + C_GF + h * 128 + ch * 8) = *(const LAS v4u*)(FT + row * HP + ch * 8);
                *(GAS v4u*)(PROJ + (size_t)(t0 + row) * PJ + C_GQ + h * 128 + ch * 8) = *(const LAS v4u*)(QT + row * HP + ch * 8); }
            __syncthreads();
        }
    }
}


__device__ __forceinline__ void scan_ssd_naive(const Args& a, unsigned char* ws, int l, LAS unsigned char* lds, int b, int h, int tid) {
    bf16* PROJ = (bf16*)(ws + WS_PROJ); const float* DT = (const float*)(ws + WS_DT);
    LAS float* xs = (LAS float*)lds;
    LAS float* Bs = xs + 64 * 64;
    LAS float* Cs = Bs + 64 * 128;
    LAS float* ys = Cs + 64 * 128;
    LAS float* dts = ys + 64 * 64;
    const int p = tid >> 3, nq = tid & 7, n0 = nq * 16, g = h >> 3;
    const float aneg = -__expf(a.in[I_ALOG][l * 16 + h]), Dh = a.in[I_SD][l * 16 + h];
    float hs[16];
#pragma unroll
    for (int j = 0; j < 16; ++j) hs[j] = 0.f;
    for (int blk = 0; blk < T / 64; ++blk) {
        const size_t t0 = (size_t)b * T + blk * 64;
        for (int idx = tid; idx < 64 * 40; idx += NTHR) { const int r = idx / 40, ch = idx % 40;
            int col; LAS float* dst;
            if (ch < 8) { col = C_SX + h * 64 + ch * 8; dst = xs + r * 64 + ch * 8; }
            else if (ch < 24) { col = C_SB + g * 128 + (ch - 8) * 8; dst = Bs + r * 128 + (ch - 8) * 8; }
            else { col = C_SC + g * 128 + (ch - 24) * 8; dst = Cs + r * 128 + (ch - 24) * 8; }
            float f[8]; unpack8(*(const GAS v4u*)(PROJ + (t0 + r) * PJ + col), f);
#pragma unroll
            for (int e = 0; e < 8; ++e) dst[e] = f[e]; }
        if (tid < 64) dts[tid] = DT[(t0 + tid) * 16 + h];
        __syncthreads();
        for (int tt = 0; tt < 64; ++tt) {
            const float dt = dts[tt], dA = __expf(dt * aneg), xv = xs[tt * 64 + p], dx = dt * xv;
            float y = 0.f;
#pragma unroll
            for (int j = 0; j < 16; ++j) { hs[j] = dA * hs[j] + dx * Bs[tt * 128 + n0 + j]; y += Cs[tt * 128 + n0 + j] * hs[j]; }
            y += __shfl_xor(y, 1); y += __shfl_xor(y, 2); y += __shfl_xor(y, 4);
            if (nq == 0) ys[tt * 64 + p] = y + Dh * xv;
        }
        __syncthreads();
        { const int r = tid >> 3, c8 = (tid & 7) * 8; float o[8];
#pragma unroll
          for (int e = 0; e < 8; ++e) o[e] = ys[r * 64 + c8 + e];
          *(GAS v4u*)(PROJ + (t0 + r) * PJ + C_SX + h * 64 + c8) = pack8(o); }
        __syncthreads();
    }
}
__device__ __forceinline__ void scan_ml_naive(const Args& a, unsigned char* ws, int l, LAS unsigned char* lds, int b, int h, int tid) {
    const bf16* PROJ = (const bf16*)(ws + WS_PROJ); const bf16* QK = (const bf16*)(ws + WS_XN); bf16* SCR = (bf16*)(ws + WS_SCR);
    const float* IFB = (const float*)(ws + WS_IF); const bf16* WQKV = (const bf16*)(ws + WS_WQKV);
    LAS float* qs = (LAS float*)lds;
    LAS float* ks = qs + 64 * 128;
    LAS float* ms = ks + 64 * 128;
    LAS float* hs = ms + 64 * 128;
    LAS float* is = hs + 64 * 128;
    LAS float* fs = is + 64;
    const int dv = tid >> 2, eq = tid & 3, e0 = eq * 32;
    float wv[32];
    { const GAS v4u* wr = (const GAS v4u*)(WQKV + ((size_t)(2 * 4 + h) * 128 + dv) * 128 + e0);
#pragma unroll
      for (int c = 0; c < 4; ++c) { float f[8]; unpack8(wr[c], f);
#pragma unroll
          for (int e = 0; e < 8; ++e) wv[c * 8 + e] = f[e]; } }
    float Cst[32], nst[32];
#pragma unroll
    for (int j = 0; j < 32; ++j) { Cst[j] = 0.f; nst[j] = 0.f; }
    const float qscale = 0.08838834764831845f;
    for (int blk = 0; blk < T / 64; ++blk) {
        const size_t t0 = (size_t)b * T + blk * 64;
        for (int idx = tid; idx < 64 * 48; idx += NTHR) { const int r = idx / 48, ch = idx % 48;
            const bf16* src; LAS float* dst;
            if (ch < 16) { src = QK + (t0 + r) * 1024 + h * 128 + ch * 8; dst = qs + r * 128 + ch * 8; }
            else if (ch < 32) { src = QK + (t0 + r) * 1024 + 512 + h * 128 + (ch - 16) * 8; dst = ks + r * 128 + (ch - 16) * 8; }
            else { src = PROJ + (t0 + r) * PJ + C_MX + h * 128 + (ch - 32) * 8; dst = ms + r * 128 + (ch - 32) * 8; }
            float f[8]; unpack8(*(const GAS v4u*)src, f);
#pragma unroll
            for (int e = 0; e < 8; ++e) dst[e] = f[e]; }
        if (tid < 64) { is[tid] = IFB[(t0 + tid) * 8 + h]; fs[tid] = IFB[(t0 + tid) * 8 + 4 + h]; }
        __syncthreads();
        for (int tt = 0; tt < 64; ++tt) {
            float v = 0.f;
#pragma unroll
            for (int j = 0; j < 32; ++j) v += ms[tt * 128 + e0 + j] * wv[j];
            v += __shfl_xor(v, 1); v += __shfl_xor(v, 2);
            const float f = __expf(fs[tt]), ig = __expf(is[tt]), iv = ig * v;
            float num = 0.f, den = 0.f;
#pragma unroll
            for (int j = 0; j < 32; ++j) { const float kk = ks[tt * 128 + e0 + j], qq = qs[tt * 128 + e0 + j] * qscale;
                Cst[j] = f * Cst[j] + iv * kk; nst[j] = f * nst[j] + ig * kk; num += Cst[j] * qq; den += nst[j] * qq; }
            num += __shfl_xor(num, 1); num += __shfl_xor(num, 2); den += __shfl_xor(den, 1); den += __shfl_xor(den, 2);
            if (eq == 0) hs[tt * 128 + dv] = num / fmaxf(fabsf(den), 1.0f);
        }
        __syncthreads();
        for (int idx = tid; idx < 64 * 16; idx += NTHR) { const int r = idx >> 4, c8 = (idx & 15) * 8; float o[8];
#pragma unroll
            for (int e = 0; e < 8; ++e) o[e] = hs[r * 128 + c8 + e];
            *(GAS v4u*)(SCR + (t0 + r) * 1024 + h * 128 + c8) = pack8(o); }
        __syncthreads();
    }
}
__device__ __forceinline__ void scan_hg_naive(const Args& a, unsigned char* ws, int l, LAS unsigned char* lds, int b, int h, int tid) {
    const bf16* PROJ = (const bf16*)(ws + WS_PROJ); bf16* SCR = (bf16*)(ws + WS_SCR);
    LAS float* fs = (LAS float*)lds;
    LAS float* ks = fs + 32 * 128;
    LAS float* qs = ks + 32 * 128;
    LAS float* vs = qs + 32 * 128;
    LAS float* os = vs + 32 * 128;
    const int dv = tid >> 2, kq = tid & 3, k0 = kq * 32;
    float S[32];
#pragma unroll
    for (int j = 0; j < 32; ++j) S[j] = 0.f;
    const float* hlb = a.in[I_HLB];
    for (int blk = 0; blk < T / 32; ++blk) {
        const size_t t0 = (size_t)b * T + blk * 32;
        for (int idx = tid; idx < 32 * 16; idx += NTHR) { const int r = idx >> 4, c8 = (idx & 15) * 8; const int c = h * 128 + c8;
            float gq[8], gf[8], gi[8];
            unpack8(*(const GAS v4u*)(PROJ + (t0 + r) * PJ + C_GQ + c), gq); unpack8(*(const GAS v4u*)(PROJ + (t0 + r) * PJ + C_GF + c), gf); unpack8(*(const GAS v4u*)(PROJ + (t0 + r) * PJ + C_GI + c), gi);
#pragma unroll
            for (int e = 0; e < 8; ++e) { const float lb = hg_lower_bound(hlb, l, c + e); const float sg = sigm(gf[e]);
                fs[r * 128 + c8 + e] = lb + (1.f - lb) * sg; ks[r * 128 + c8 + e] = (1.f - lb) * (1.f - sg); qs[r * 128 + c8 + e] = siluf(gq[e]); vs[r * 128 + c8 + e] = gi[e]; } }
        __syncthreads();
        for (int tt = 0; tt < 32; ++tt) {
            const float v = vs[tt * 128 + dv]; float o = 0.f;
#pragma unroll
            for (int j = 0; j < 32; ++j) { S[j] = fs[tt * 128 + k0 + j] * S[j] + ks[tt * 128 + k0 + j] * v; o += S[j] * qs[tt * 128 + k0 + j]; }
            o += __shfl_xor(o, 1); o += __shfl_xor(o, 2);
            if (kq == 0) os[tt * 128 + dv] = o;
        }
        __syncthreads();
        { const int r = tid >> 4, c8 = (tid & 15) * 8; float o[8];
#pragma unroll
          for (int e = 0; e < 8; ++e) o[e] = os[r * 128 + c8 + e];
          *(GAS v4u*)(SCR + (t0 + r) * 1024 + 512 + h * 128 + c8) = pack8(o); }
        __syncthreads();
    }
}

constexpr int LP = 136;
__device__ __forceinline__ s16x8 ldfrag(const LAS bf16* base, int row0, int k0, int lane) {
    return *(const LAS s16x8*)(base + (row0 + (lane & 15)) * LP + k0 + (lane >> 4) * 8);
}
__device__ __forceinline__ unsigned short bfelem(const v4u v, int j) { const unsigned wd = v[j >> 1]; return (unsigned short)((j & 1) ? (wd >> 16) : (wd & 0xffffu)); }

constexpr int LQ = 72;
__device__ __forceinline__ s16x8 ldfrag72(const LAS bf16* base, int row0, int k0, int lane);
typedef short s16x4v __attribute__((ext_vector_type(4)));
__device__ __forceinline__ s16x8 ldfrag_tr(const LAS bf16* Tt, int pitch, int k0, int col0, int lane) {
    const LAS bf16* a0 = Tt + (k0 + 8 * (lane >> 4) + ((lane & 15) >> 2)) * pitch + col0 + 4 * (lane & 3);
    const s16x4v lo = __builtin_amdgcn_ds_read_tr16_b64_v4i16((LAS s16x4v*)a0), hi = __builtin_amdgcn_ds_read_tr16_b64_v4i16((LAS s16x4v*)(a0 + 4 * pitch));
    return (s16x8){lo.x, lo.y, lo.z, lo.w, hi.x, hi.y, hi.z, hi.w};
}
constexpr int XP = 40;
__device__ __forceinline__ void scan_ssd(const Args& a, unsigned char* ws, int l, LAS unsigned char* lds, int b, int h, int ph, int tid_in) {
    int tid = tid_in; asm volatile("" : "+v"(tid));
    bf16* PROJ = (bf16*)(ws + WS_PROJ); const float* DT = (const float*)(ws + WS_DT);
#define SSD_BM(X) ((LAS bf16*)(lds + (X) * 17408))
#define SSD_CM(X) ((LAS bf16*)(lds + 34816 + (X) * 17408))
#define SSD_SS(X) ((LAS bf16*)(lds + 69632 + (X) * 9216))
#define SSD_X(X)  ((LAS bf16*)(lds + 88064 + (X) * 5120))
#define SSD_XS(X) ((LAS bf16*)(lds + 98304 + (X) * 5120))
    LAS bf16* ST = (LAS bf16*)(lds + 108544);
#define SSD_CUM(X) ((LAS float*)(lds + 117248 + (X) * 256))
    LAS float* dts = (LAS float*)(lds + 117760);
    LAS float* wtab = (LAS float*)(lds + 118016);
    const int lane = tid & 63, w = __builtin_amdgcn_readfirstlane(tid >> 6), q = lane >> 4, r = lane & 15, g = h >> 3;
    const bool prod = w < 4; const int j4 = w & 3, gt = tid & 255;
    const float Dh = a.in[I_SD][l * 16 + h];
    const int colx = C_SX + h * 64 + ph * 32, colB = C_SB + g * 128, colC = C_SC + g * 128;
    f32x4 st[2][2];
#pragma unroll
    for (int kt = 0; kt < 2; ++kt) { st[kt][0] = (f32x4){0.f, 0.f, 0.f, 0.f}; st[kt][1] = (f32x4){0.f, 0.f, 0.f, 0.f}; }
    for (int i = tid; i < 32 * LP / 2; i += NTHR) ((LAS unsigned*)ST)[i] = 0u;
    v4u rb[4], rc[4], rx; float fd = 0.f, fc = 0.f;
#pragma unroll
    for (int i = 0; i < 4; ++i) { rb[i] = (v4u){0u, 0u, 0u, 0u}; rc[i] = (v4u){0u, 0u, 0u, 0u}; }
    rx = (v4u){0u, 0u, 0u, 0u};
    const float* SC64 = (const float*)(ws + ((b < 2) ? WS_SC64A : WS_SC64B)) + (size_t)(b & 1) * T * 16;
    const int vrow = gt >> 2, vch = gt & 3;
#define SSD_LOAD(cc) do { const size_t t0_ = (size_t)b * T + (size_t)(cc) * 64; \
        _Pragma("unroll") for (int i = 0; i < 4; ++i) { const int idx = gt + 256 * i, row = idx >> 4, ch = idx & 15; \
            rb[i] = *(const GAS v4u*)(PROJ + (t0_ + row) * PJ + colB + ch * 8); rc[i] = *(const GAS v4u*)(PROJ + (t0_ + row) * PJ + colC + ch * 8); } \
        rx = *(const GAS v4u*)(PROJ + (t0_ + vrow) * PJ + colx + vch * 8); \
        fd = DT[(t0_ + lane) * 16 + h]; fc = SC64[((size_t)(cc) * 64 + lane) * 16 + h]; } while (0)
    unsigned ob[2][2] = {{0u, 0u}, {0u, 0u}};
#define SSD_STORE(cc) do { bf16* op_ = PROJ + ((size_t)b * T + (size_t)(cc) * 64 + 16 * j4 + 4 * q) * PJ + colx + r; \
        _Pragma("unroll") for (int pt = 0; pt < 2; ++pt) { op_[16 * pt] = (bf16)(ob[pt][0] & 0xffffu); op_[PJ + 16 * pt] = (bf16)(ob[pt][0] >> 16); \
            op_[2 * PJ + 16 * pt] = (bf16)(ob[pt][1] & 0xffffu); op_[3 * PJ + 16 * pt] = (bf16)(ob[pt][1] >> 16); } } while (0)
    if (prod) SSD_LOAD(0);
    LDS_BARRIER();
    s16x8 xf[2][2];
#pragma unroll
    for (int pt = 0; pt < 2; ++pt) { xf[pt][0] = (s16x8){0, 0, 0, 0, 0, 0, 0, 0}; xf[pt][1] = (s16x8){0, 0, 0, 0, 0, 0, 0, 0}; }
#pragma unroll 1
    for (int c = -1; c < T / 64; ++c) {
        const int n = c + 1, bb = n & 1, cb = c & 1;
        if (prod) {
            if (n < T / 64) {
#pragma unroll
                for (int i = 0; i < 4; ++i) { const int idx = gt + 256 * i, row = idx >> 4, ch = idx & 15;
                    *(LAS v4u*)(SSD_BM(bb) + row * LP + ch * 8) = rb[i]; *(LAS v4u*)(SSD_CM(bb) + row * LP + ch * 8) = rc[i]; }
                *(LAS v4u*)(SSD_X(bb) + vrow * XP + vch * 8) = rx;
                const float ce = __int_as_float(__builtin_amdgcn_readlane(__float_as_int(fc), 63));
                {
                    const float sv = __shfl(fd * __expf(ce - fc), 16 * j4 + (lane >> 2)); float xs_[8]; unpack8(rx, xs_);
#pragma unroll
                    for (int jj = 0; jj < 8; ++jj) xs_[jj] *= sv;
                    *(LAS v4u*)(SSD_XS(bb) + vrow * XP + vch * 8) = pack8(xs_); }
                if (w == 0) { SSD_CUM(bb)[lane] = fc; dts[lane] = fd; }
                else { const float cref = __int_as_float(__builtin_amdgcn_readlane(__float_as_int(fc), 16 * j4 - 1)); wtab[j4 * 64 + lane] = fd * __expf(fminf(cref - fc, 0.f)); }
                if (n + 1 < T / 64) SSD_LOAD(n + 1);
            }
        } else if (c >= 0) {
            s16x8 cf[4], sf[2][4], sa[2];
#pragma unroll
            for (int ks = 0; ks < 2; ++ks) { sa[ks] = ldfrag72(SSD_SS(cb), 16 * j4, 32 * ks, lane); xf[0][ks] = ldfrag_tr(SSD_X(cb), XP, 32 * ks, 0, lane); xf[1][ks] = ldfrag_tr(SSD_X(cb), XP, 32 * ks, 16, lane); }
#pragma unroll
            for (int ks = 0; ks < 4; ++ks) { cf[ks] = ldfrag(SSD_CM(cb), 16 * j4, 32 * ks, lane); sf[0][ks] = ldfrag(ST, 0, 32 * ks, lane); sf[1][ks] = ldfrag(ST, 16, 32 * ks, lane); }
            const f32x4 cl4 = *(const LAS f32x4*)(SSD_CUM(cb) + 16 * j4 + 4 * q);
            unsigned short xr[2][4];
#pragma unroll
            for (int pt = 0; pt < 2; ++pt)
#pragma unroll
                for (int i = 0; i < 4; ++i) xr[pt][i] = SSD_X(cb)[(16 * j4 + 4 * q + i) * XP + 16 * pt + r];
            SCHED_FENCE();
            f32x4 d3[2], d2[2];
#pragma unroll
            for (int pt = 0; pt < 2; ++pt) { d3[pt] = (f32x4){0.f, 0.f, 0.f, 0.f}; d2[pt] = (f32x4){0.f, 0.f, 0.f, 0.f}; }
#pragma unroll
            for (int ks = 0; ks < 2; ++ks) { d2[0] = MFMA16(sa[ks], xf[0][ks], d2[0]); d2[1] = MFMA16(sa[ks], xf[1][ks], d2[1]); }
#pragma unroll
            for (int ks = 0; ks < 4; ++ks) { d3[0] = MFMA16(cf[ks], sf[0][ks], d3[0]); d3[1] = MFMA16(cf[ks], sf[1][ks], d3[1]); }
            SCHED_FENCE();
            if (c > 0) SSD_STORE(c - 1);
            float el[4];
#pragma unroll
            for (int i = 0; i < 4; ++i) el[i] = __expf(cl4[i]);
#pragma unroll
            for (int pt = 0; pt < 2; ++pt) { float y4[4]; const float x4[4] = {bf2f(xr[pt][0]), bf2f(xr[pt][1]), bf2f(xr[pt][2]), bf2f(xr[pt][3])};
#pragma unroll
                for (int i = 0; i < 4; ++i) y4[i] = d2[pt][i] + el[i] * d3[pt][i] + Dh * x4[i];
                ob[pt][0] = pk2(y4[0], y4[1]); ob[pt][1] = pk2(y4[2], y4[3]); }
        }
        LDS_BARRIER();
        if (prod) {
            if (n < T / 64) {
                int lrow = 16 * j4 + r; asm volatile("" : "+v"(lrow));
                const LAS float* cum = SSD_CUM(bb);
                const LAS float* wt = wtab + j4 * 64;
                s16x8 cf[4], fa[2][4];
#pragma unroll
                for (int ks = 0; ks < 4; ++ks) cf[ks] = ldfrag(SSD_CM(bb), 16 * j4, 32 * ks, lane);
#pragma unroll
                for (int si = 0; si < 2; ++si)
#pragma unroll
                    for (int ks = 0; ks < 4; ++ks) fa[si][ks] = ldfrag(SSD_BM(bb), 16 * si, 32 * ks, lane);
                const float cl = cum[lrow], cref = cum[(j4 > 0) ? 16 * j4 - 1 : 0];
                const f32x4 cs = *(const LAS f32x4*)(cum + 16 * j4 + 4 * q), ds = *(const LAS f32x4*)(dts + 16 * j4 + 4 * q);
                f32x4 wt4[3];
#pragma unroll
                for (int si = 0; si < 3; ++si) wt4[si] = *(const LAS f32x4*)(wt + 16 * si + 4 * q);
                SCHED_FENCE();
                f32x4 d[4];
#pragma unroll
                for (int si = 0; si < 4; ++si) d[si] = (f32x4){0.f, 0.f, 0.f, 0.f};
#pragma unroll
                for (int ks = 0; ks < 4; ++ks)
#pragma unroll
                    for (int si = 0; si < 2; ++si) d[si] = MFMA16(fa[si][ks], cf[ks], d[si]);
                if (j4 >= 2) {
                    s16x8 fb[2][4];
#pragma unroll
                    for (int si = 0; si < 2; ++si)
#pragma unroll
                        for (int ks = 0; ks < 4; ++ks) fb[si][ks] = ldfrag(SSD_BM(bb), 16 * (2 + si), 32 * ks, lane);
                    SCHED_FENCE();
#pragma unroll
                    for (int ks = 0; ks < 4; ++ks)
#pragma unroll
                        for (int si = 0; si < 2; ++si) d[2 + si] = MFMA16(fb[si][ks], cf[ks], d[2 + si]);
                }
                const float rowfac = __expf(fminf(cl - cref, 0.f));
                float dg[4];
#pragma unroll
                for (int i = 0; i < 4; ++i) dg[i] = (16 * j4 + 4 * q + i <= lrow) ? __expf(fminf(cl - cs[i], 0.f)) * ds[i] : 0.f;
                SCHED_FENCE();
#pragma unroll
                for (int si = 0; si < 4; ++si) { const int s0 = 16 * si + 4 * q; float v[4];
#pragma unroll
                    for (int i = 0; i < 4; ++i) { const float fac = (si < j4) ? rowfac * wt4[si < 3 ? si : 2][i] : ((si == j4) ? dg[i] : 0.f); v[i] = (si <= j4) ? d[si][i] * fac : 0.f; }
                    v2u o; o.x = pk2(v[0], v[1]); o.y = pk2(v[2], v[3]); *(LAS v2u*)(SSD_SS(bb) + lrow * LQ + s0) = o; }
            }
        } else if (c >= 0) {
            s16x8 ba[2][2], xsf[2][2];
#pragma unroll
            for (int kt = 0; kt < 2; ++kt)
#pragma unroll
                for (int ks = 0; ks < 2; ++ks) ba[kt][ks] = ldfrag_tr(SSD_BM(cb), LP, 32 * ks, 16 * (2 * j4 + kt), lane);
#pragma unroll
            for (int pt = 0; pt < 2; ++pt)
#pragma unroll
                for (int ks = 0; ks < 2; ++ks) xsf[pt][ks] = ldfrag_tr(SSD_XS(cb), XP, 32 * ks, 16 * pt, lane);
            const float dec = __expf(SSD_CUM(cb)[63]);
#pragma unroll
            for (int kt = 0; kt < 2; ++kt) { st[kt][0] = st[kt][0] * dec; st[kt][1] = st[kt][1] * dec; }
            SCHED_FENCE();
#pragma unroll
            for (int ks = 0; ks < 2; ++ks)
#pragma unroll
                for (int kt = 0; kt < 2; ++kt) { st[kt][0] = MFMA16(ba[kt][ks], xsf[0][ks], st[kt][0]); st[kt][1] = MFMA16(ba[kt][ks], xsf[1][ks], st[kt][1]); }
            SCHED_FENCE();
#pragma unroll
            for (int kt = 0; kt < 2; ++kt)
#pragma unroll
                for (int pt = 0; pt < 2; ++pt) { v2u o; o.x = pk2(st[kt][pt][0], st[kt][pt][1]); o.y = pk2(st[kt][pt][2], st[kt][pt][3]);
                    *(LAS v2u*)(ST + (16 * pt + r) * LP + 16 * (2 * j4 + kt) + 4 * q) = o; }
        }
        LDS_BARRIER();
    }
    if (!prod) SSD_STORE(T / 64 - 1);
#undef SSD_STORE
#undef SSD_LOAD
#undef SSD_CM
#undef SSD_BM
#undef SSD_XS
#undef SSD_SS
#undef SSD_X
#undef SSD_CUM
}
__device__ __forceinline__ s16x8 ldfrag72(const LAS bf16* base, int row0, int k0, int lane);
__device__ __forceinline__ void scan_ml(const Args& a, unsigned char* ws, int l, LAS unsigned char* lds, int b, int h, int dq, int tid_in) {
    int tid = tid_in; asm volatile("" : "+v"(tid));
    const bf16* QK = (const bf16*)(ws + WS_XN); bf16* SCR = (bf16*)(ws + WS_SCR); const float* IFB = (const float*)(ws + WS_IF);
    const float* MLC = (const float*)(ws + WS_MLC); const float* MLP = (const float*)(ws + WS_MLP);
    constexpr int LQ_ = 72, VSP = 56;
#define ML_Q(X)  ((LAS bf16*)(lds + (X) * 17408))
#define ML_K(X)  ((LAS bf16*)(lds + 34816 + (X) * 17408))
#define ML_P(X)  ((LAS bf16*)(lds + 69632 + (X) * 9216))
#define ML_V(X)  ((LAS bf16*)(lds + 88064 + (X) * 5120))
#define ML_VS(X) ((LAS bf16*)(lds + 98304 + (X) * 7168))
    LAS bf16* CS = (LAS bf16*)(lds + 112640);
    LAS bf16* NS = (LAS bf16*)(lds + 121344);
#define ML_VEC(X) ((LAS float*)(lds + 125696 + (X) * 1024))
    LAS float* rowfv = (LAS float*)(lds + 127744);
    LAS float* colfv = rowfv + 64;
    LAS float* denv = (LAS float*)(lds + 128256);
    const int lane = tid & 63, w = __builtin_amdgcn_readfirstlane(tid >> 6), q = lane >> 4, r = lane & 15;
    const bool prod = w < 4; const int j4 = w & 3, gt = tid & 255;
    const float qscale = 0.08838834764831845f;
    f32x4 cst[2][2], nreg[2];
#pragma unroll
    for (int et = 0; et < 2; ++et) { cst[et][0] = (f32x4){0.f, 0.f, 0.f, 0.f}; cst[et][1] = (f32x4){0.f, 0.f, 0.f, 0.f}; nreg[et] = (f32x4){0.f, 0.f, 0.f, 0.f}; }
    float m_s = 0.f;
    for (int i = tid; i < (32 + 16) * LP / 2; i += NTHR) ((LAS unsigned*)CS)[i] = 0u;
    for (int i = tid; i < 2 * 64 * VSP / 2; i += NTHR) ((LAS unsigned*)ML_VS(0))[i] = 0u;
    v4u rq[4], rk[4], rv, rvk; float pli = 0.f, pc = 0.f, pp = 0.f;
#pragma unroll
    for (int i = 0; i < 4; ++i) { rq[i] = (v4u){0u, 0u, 0u, 0u}; rk[i] = (v4u){0u, 0u, 0u, 0u}; }
    rv = (v4u){0u, 0u, 0u, 0u}; rvk = rv;
    const int vrow = gt >> 2, vch = gt & 3;
#define ML_LOAD(cc) do { const size_t t0_ = (size_t)b * T + (size_t)(cc) * 64; \
        _Pragma("unroll") for (int i = 0; i < 4; ++i) { const int idx = gt + 256 * i, row = idx >> 4, ch = idx & 15; \
            rq[i] = *(const GAS v4u*)(QK + (t0_ + row) * 1024 + h * 128 + ch * 8); rk[i] = *(const GAS v4u*)(QK + (t0_ + row) * 1024 + 512 + h * 128 + ch * 8); } \
        rv = *(const GAS v4u*)(SCR + (t0_ + vrow) * 1024 + 512 + h * 128 + dq * 32 + vch * 8); \
        if (w == 0) { pli = IFB[(t0_ + lane) * 8 + h]; pc = MLC[(t0_ + lane) * 4 + h]; pp = MLP[(t0_ + lane) * 4 + h]; } } while (0)
    unsigned ob[4] = {0u, 0u, 0u, 0u};
#define ML_STORE(cc) do { bf16* op_ = SCR + ((size_t)b * T + (size_t)(cc) * 64 + 16 * j4 + 4 * q) * 1024 + h * 128 + dq * 32 + r; \
        _Pragma("unroll") for (int dvt = 0; dvt < 2; ++dvt) { op_[16 * dvt] = (bf16)(ob[2 * dvt] & 0xffffu); op_[1024 + 16 * dvt] = (bf16)(ob[2 * dvt] >> 16); \
            op_[2048 + 16 * dvt] = (bf16)(ob[2 * dvt + 1] & 0xffffu); op_[3072 + 16 * dvt] = (bf16)(ob[2 * dvt + 1] >> 16); } } while (0)
    if (prod) ML_LOAD(0);
    LDS_BARRIER();
    f32x4 d2[2], d3[2];
    d2[0] = d2[1] = d3[0] = d3[1] = (f32x4){0.f, 0.f, 0.f, 0.f};
#pragma unroll 1
    for (int c = -1; c < T / 64; ++c) {
        const int n = c + 1, bb = n & 1, cb = c & 1;
        if (prod) {
            if (n < T / 64) {
#pragma unroll
                for (int i = 0; i < 4; ++i) { const int idx = gt + 256 * i, row = idx >> 4, ch = idx & 15;
                    *(LAS v4u*)(ML_Q(bb) + row * LP + ch * 8) = rq[i]; *(LAS v4u*)(ML_K(bb) + row * LP + ch * 8) = rk[i]; }
                *(LAS v4u*)(ML_V(bb) + vrow * XP + vch * 8) = rv; rvk = rv;
                if (w == 0) {
                    const float g = __int_as_float(__builtin_amdgcn_readlane(__float_as_int(pp), 63)), cend = __int_as_float(__builtin_amdgcn_readlane(__float_as_int(pc), 63));
                    const float mloc = cend + g;
                    const float mt_ = fmaxf(pc + m_s, pc + pp);
                    const float m_new = fmaxf(cend + m_s, mloc);
                    LAS float* vb_ = ML_VEC(bb);
                    vb_[lane] = __expf(pc + m_s - mt_); vb_[64 + lane] = __expf(-mt_);
                    rowfv[lane] = qscale * __expf(fminf(pc + g - mt_, 80.f)); colfv[lane] = __expf(pli - pc - g);
                    if (lane == 0) { vb_[192] = __expf(cend + m_s - m_new); vb_[193] = __expf(mloc - m_new); }
                    m_s = m_new;
                }
                if (n + 1 < T / 64) ML_LOAD(n + 1);
            }
        } else if (c >= 0) {
            const LAS float* vc_ = ML_VEC(cb);
            s16x8 qf[4], cfr[2][4], nsf[4], pf[2], v0[2], v1[2];
#pragma unroll
            for (int ks = 0; ks < 2; ++ks) { pf[ks] = ldfrag72(ML_P(cb), 16 * j4, 32 * ks, lane); v0[ks] = ldfrag_tr(ML_V(cb), XP, 32 * ks, 0, lane); v1[ks] = ldfrag_tr(ML_V(cb), XP, 32 * ks, 16, lane); }
#pragma unroll
            for (int ks = 0; ks < 4; ++ks) { qf[ks] = ldfrag(ML_Q(cb), 16 * j4, 32 * ks, lane); cfr[0][ks] = ldfrag(CS, 0, 32 * ks, lane); cfr[1][ks] = ldfrag(CS, 16, 32 * ks, lane); nsf[ks] = ldfrag(NS, 0, 32 * ks, lane); }
            const f32x4 rs4 = *(const LAS f32x4*)(vc_ + 128 + 16 * j4 + 4 * q), wi4 = *(const LAS f32x4*)(vc_ + 16 * j4 + 4 * q), em4 = *(const LAS f32x4*)(vc_ + 64 + 16 * j4 + 4 * q);
            SCHED_FENCE();
            f32x4 dn = (f32x4){0.f, 0.f, 0.f, 0.f};
            d2[0] = (f32x4){0.f, 0.f, 0.f, 0.f}; d2[1] = (f32x4){0.f, 0.f, 0.f, 0.f}; d3[0] = (f32x4){0.f, 0.f, 0.f, 0.f}; d3[1] = (f32x4){0.f, 0.f, 0.f, 0.f};
#pragma unroll
            for (int ks = 0; ks < 2; ++ks) { d2[0] = MFMA16(pf[ks], v0[ks], d2[0]); d2[1] = MFMA16(pf[ks], v1[ks], d2[1]); }
#pragma unroll
            for (int ks = 0; ks < 4; ++ks) { d3[0] = MFMA16(qf[ks], cfr[0][ks], d3[0]); d3[1] = MFMA16(qf[ks], cfr[1][ks], d3[1]); dn = MFMA16(qf[ks], nsf[ks], dn); }
            SCHED_FENCE();
            if (r == 0) { f32x4 de;
#pragma unroll
                for (int i = 0; i < 4; ++i) de[i] = fmaxf(fabsf(rs4[i] + wi4[i] * qscale * dn[i]), em4[i]);
                *(LAS f32x4*)(denv + 16 * j4 + 4 * q) = de; }
        }
        LDS_BARRIER();
        if (prod) {
            if (n < T / 64) {
                int lrow = 16 * j4 + r; asm volatile("" : "+v"(lrow));
                s16x8 qf[4], fa[2][4]; f32x4 cf4[4];
#pragma unroll
                for (int ks = 0; ks < 4; ++ks) qf[ks] = ldfrag(ML_Q(bb), 16 * j4, 32 * ks, lane);
#pragma unroll
                for (int si = 0; si < 2; ++si)
#pragma unroll
                    for (int ks = 0; ks < 4; ++ks) fa[si][ks] = ldfrag(ML_K(bb), 16 * si, 32 * ks, lane);
                const float a_loc = ML_VEC(bb)[193], rf = rowfv[lrow];
                const float wv = colfv[vrow] * a_loc;
#pragma unroll
                for (int si = 0; si < 4; ++si) cf4[si] = *(const LAS f32x4*)(colfv + 16 * si + 4 * q);
                SCHED_FENCE();
                { float f8[8]; unpack8(rvk, f8);
#pragma unroll
                  for (int jj = 0; jj < 8; ++jj) f8[jj] *= wv;
                  *(LAS v4u*)(ML_VS(bb) + vrow * VSP + vch * 8) = pack8(f8);
                  if (vch == 0) { v4u o = (v4u){f2bf(wv), 0u, 0u, 0u}; *(LAS v4u*)(ML_VS(bb) + vrow * VSP + 32) = o; } }
                f32x4 d1[4];
#pragma unroll
                for (int si = 0; si < 4; ++si) d1[si] = (f32x4){0.f, 0.f, 0.f, 0.f};
#pragma unroll
                for (int ks = 0; ks < 4; ++ks)
#pragma unroll
                    for (int si = 0; si < 2; ++si) d1[si] = MFMA16(fa[si][ks], qf[ks], d1[si]);
                if (j4 >= 2) {
                    s16x8 fb[2][4];
#pragma unroll
                    for (int si = 0; si < 2; ++si)
#pragma unroll
                        for (int ks = 0; ks < 4; ++ks) fb[si][ks] = ldfrag(ML_K(bb), 16 * (2 + si), 32 * ks, lane);
                    SCHED_FENCE();
#pragma unroll
                    for (int ks = 0; ks < 4; ++ks)
#pragma unroll
                        for (int si = 0; si < 2; ++si) d1[2 + si] = MFMA16(fb[si][ks], qf[ks], d1[2 + si]);
                }
                SCHED_FENCE();
                float rowsum = 0.f;
#pragma unroll
                for (int si = 0; si < 4; ++si) { const int s0 = 16 * si + 4 * q; float v[4];
#pragma unroll
                    for (int i = 0; i < 4; ++i) { v[i] = (s0 + i <= lrow) ? d1[si][i] * (rf * cf4[si][i]) : 0.f; rowsum += v[i]; }
                    v2u o; o.x = pk2(v[0], v[1]); o.y = pk2(v[2], v[3]); *(LAS v2u*)(ML_P(bb) + lrow * LQ_ + s0) = o; }
                rowsum += __shfl_xor(rowsum, 16); rowsum += __shfl_xor(rowsum, 32);
                if (q == 0) ML_VEC(bb)[128 + lrow] = rowsum;
            }
        } else if (c >= 0) {
            const LAS float* vc_ = ML_VEC(cb);
            s16x8 kf[2][2], vs[3][2];
#pragma unroll
            for (int et = 0; et < 2; ++et)
#pragma unroll
                for (int ks = 0; ks < 2; ++ks) kf[et][ks] = ldfrag_tr(ML_K(cb), LP, 32 * ks, 16 * (2 * j4 + et), lane);
#pragma unroll
            for (int t3 = 0; t3 < 3; ++t3)
#pragma unroll
                for (int ks = 0; ks < 2; ++ks) vs[t3][ks] = ldfrag_tr(ML_VS(cb), VSP, 32 * ks, 16 * t3, lane);
            const f32x4 wi4 = *(const LAS f32x4*)(vc_ + 16 * j4 + 4 * q), dn4 = *(const LAS f32x4*)(denv + 16 * j4 + 4 * q);
            const float a_old = vc_[192];
            SCHED_FENCE();
            if (c > 0) ML_STORE(c - 1);
#pragma unroll
            for (int et = 0; et < 2; ++et) { cst[et][0] = cst[et][0] * a_old; cst[et][1] = cst[et][1] * a_old; nreg[et] = nreg[et] * a_old; }
#pragma unroll
            for (int ks = 0; ks < 2; ++ks)
#pragma unroll
                for (int et = 0; et < 2; ++et) { cst[et][0] = MFMA16(kf[et][ks], vs[0][ks], cst[et][0]); cst[et][1] = MFMA16(kf[et][ks], vs[1][ks], cst[et][1]); nreg[et] = MFMA16(kf[et][ks], vs[2][ks], nreg[et]); }
#pragma unroll
            for (int dvt = 0; dvt < 2; ++dvt) { float o4[4];
#pragma unroll
                for (int i = 0; i < 4; ++i) o4[i] = (d2[dvt][i] + wi4[i] * qscale * d3[dvt][i]) * __builtin_amdgcn_rcpf(dn4[i]);
                ob[2 * dvt] = pk2(o4[0], o4[1]); ob[2 * dvt + 1] = pk2(o4[2], o4[3]); }
            SCHED_FENCE();
#pragma unroll
            for (int et = 0; et < 2; ++et) {
#pragma unroll
                for (int dvt = 0; dvt < 2; ++dvt) { v2u o; o.x = pk2(cst[et][dvt][0], cst[et][dvt][1]); o.y = pk2(cst[et][dvt][2], cst[et][dvt][3]);
                    *(LAS v2u*)(CS + (16 * dvt + r) * LP + 16 * (2 * j4 + et) + 4 * q) = o; }
                if (r == 0) { v2u o; o.x = pk2(nreg[et][0], nreg[et][1]); o.y = pk2(nreg[et][2], nreg[et][3]); *(LAS v2u*)(NS + 16 * (2 * j4 + et) + 4 * q) = o; } }
        }
        LDS_BARRIER();
    }
    if (!prod) ML_STORE(T / 64 - 1);
}
#undef ML_LOAD
#undef ML_STORE
#undef ML_Q
#undef ML_K
#undef ML_P
#undef ML_V
#undef ML_VS
#undef ML_VEC
__device__ __forceinline__ s16x8 ldfrag72(const LAS bf16* base, int row0, int k0, int lane) {
    return *(const LAS s16x8*)(base + (row0 + (lane & 15)) * LQ + k0 + (lane >> 4) * 8);
}
__device__ __forceinline__ void scan_hg(const Args& a, unsigned char* ws, int l, LAS unsigned char* lds, int b, int h, int dq, int tid_in) {
    int tid = tid_in; asm volatile("" : "+v"(tid));
    const bf16* PROJ = (const bf16*)(ws + WS_PROJ); bf16* PROJW = (bf16*)(ws + WS_PROJ); const float* HGV = (const float*)(ws + WS_HGV);
#define HG_QM(X) ((LAS bf16*)(lds + (X) * 17408))
#define HG_KM(X) ((LAS bf16*)(lds + 34816 + (X) * 17408))
#define HG_P(X)  ((LAS bf16*)(lds + 69632 + (X) * 9216))
#define HG_V(X)  ((LAS bf16*)(lds + 88064 + (X) * 5120))
    LAS bf16* ST = (LAS bf16*)(lds + 98304);
#define HG_VEC(X) ((LAS float*)(lds + 107008 + (X) * 1536))
    const int lane = tid & 63, w = __builtin_amdgcn_readfirstlane(tid >> 6), q = lane >> 4, r = lane & 15;
    const bool prod = w < 4; const int j4 = w & 3, gt = tid & 255;
    f32x4 st[2][2];
#pragma unroll
    for (int kt = 0; kt < 2; ++kt) { st[kt][0] = (f32x4){0.f, 0.f, 0.f, 0.f}; st[kt][1] = (f32x4){0.f, 0.f, 0.f, 0.f}; }
    for (int i = tid; i < 32 * LP / 2; i += NTHR) ((LAS unsigned*)ST)[i] = 0u;
    v4u rq[4], rk[4], rv; float fv0 = 0.f, fv1 = 0.f;
#pragma unroll
    for (int i = 0; i < 4; ++i) { rq[i] = (v4u){0u, 0u, 0u, 0u}; rk[i] = (v4u){0u, 0u, 0u, 0u}; }
    rv = (v4u){0u, 0u, 0u, 0u};
    const int vrow = gt >> 2, vch = gt & 3;
#define HG_LOAD(cc) do { const size_t t0_ = (size_t)b * T + (size_t)(cc) * 64; \
        _Pragma("unroll") for (int i = 0; i < 4; ++i) { const int idx = gt + 256 * i, row = idx >> 4, ch = idx & 15; \
            rq[i] = *(const GAS v4u*)(PROJ + (t0_ + row) * PJ + C_GQ + h * 128 + ch * 8); rk[i] = *(const GAS v4u*)(PROJ + (t0_ + row) * PJ + C_GF + h * 128 + ch * 8); } \
        rv = *(const GAS v4u*)(PROJ + (t0_ + vrow) * PJ + C_GI + h * 128 + dq * 32 + vch * 8); \
        const size_t ch_ = (size_t)b * (T / 64) + (cc); \
        fv0 = HGV[(ch_ * 4 + h) * 384 + gt]; if (gt < 128) fv1 = HGV[(ch_ * 4 + h) * 384 + 256 + gt]; } while (0)
    unsigned ob[2][2] = {{0u, 0u}, {0u, 0u}};
#define HG_STORE(cc) do { bf16* op_ = PROJW + ((size_t)b * T + (size_t)(cc) * 64 + 16 * j4 + 4 * q) * PJ + C_GI + h * 128 + dq * 32 + r; \
        _Pragma("unroll") for (int dvt = 0; dvt < 2; ++dvt) { op_[16 * dvt] = (bf16)(ob[dvt][0] & 0xffffu); op_[PJ + 16 * dvt] = (bf16)(ob[dvt][0] >> 16); \
            op_[2 * PJ + 16 * dvt] = (bf16)(ob[dvt][1] & 0xffffu); op_[3 * PJ + 16 * dvt] = (bf16)(ob[dvt][1] >> 16); } } while (0)
    if (prod) HG_LOAD(0);
    LDS_BARRIER();
#pragma unroll 1
    for (int c = -1; c < T / 64; ++c) {
        const int n = c + 1, bb = n & 1, cb = c & 1;
        if (prod) {
            if (n < T / 64) {
#pragma unroll
                for (int i = 0; i < 4; ++i) { const int idx = gt + 256 * i, row = idx >> 4, ch = idx & 15;
                    *(LAS v4u*)(HG_QM(bb) + row * LP + ch * 8) = rq[i]; *(LAS v4u*)(HG_KM(bb) + row * LP + ch * 8) = rk[i]; }
                *(LAS v4u*)(HG_V(bb) + vrow * XP + vch * 8) = rv;
                HG_VEC(bb)[gt] = fv0; if (gt < 128) HG_VEC(bb)[256 + gt] = fv1;
                if (n + 1 < T / 64) HG_LOAD(n + 1);
            }
        } else if (c >= 0) {
            const LAS float* vc_ = HG_VEC(cb);
            s16x8 pfr[2], qfr[4], vf0[2], vf1[2], s0f[4], s1f[4], kf[2][2]; f32x4 ev[2], ee[2];
#pragma unroll
            for (int ks = 0; ks < 2; ++ks) { pfr[ks] = ldfrag72(HG_P(cb), 16 * j4, 32 * ks, lane); vf0[ks] = ldfrag_tr(HG_V(cb), XP, 32 * ks, 0, lane); vf1[ks] = ldfrag_tr(HG_V(cb), XP, 32 * ks, 16, lane); }
#pragma unroll
            for (int kt = 0; kt < 2; ++kt)
#pragma unroll
                for (int ks = 0; ks < 2; ++ks) kf[kt][ks] = ldfrag_tr(HG_KM(cb), LP, 32 * ks, 16 * (2 * j4 + kt), lane);
#pragma unroll
            for (int ks = 0; ks < 4; ++ks) { qfr[ks] = ldfrag(HG_QM(cb), 16 * j4, 32 * ks, lane); s0f[ks] = ldfrag(ST, 0, 32 * ks, lane); s1f[ks] = ldfrag(ST, 16, 32 * ks, lane); }
#pragma unroll
            for (int kt = 0; kt < 2; ++kt) { ev[kt] = *(const LAS f32x4*)(vc_ + 256 + 16 * (2 * j4 + kt) + 4 * q); ee[kt] = *(const LAS f32x4*)(vc_ + 128 + 16 * (2 * j4 + kt) + 4 * q); }
            SCHED_FENCE();
            f32x4 d0 = (f32x4){0.f, 0.f, 0.f, 0.f}, d1 = (f32x4){0.f, 0.f, 0.f, 0.f}, u[2][2];
#pragma unroll
            for (int kt = 0; kt < 2; ++kt) { u[kt][0] = (f32x4){0.f, 0.f, 0.f, 0.f}; u[kt][1] = (f32x4){0.f, 0.f, 0.f, 0.f}; }
#pragma unroll
            for (int ks = 0; ks < 2; ++ks) { d0 = MFMA16(pfr[ks], vf0[ks], d0); d1 = MFMA16(pfr[ks], vf1[ks], d1);
#pragma unroll
                for (int kt = 0; kt < 2; ++kt) { u[kt][0] = MFMA16(kf[kt][ks], vf0[ks], u[kt][0]); u[kt][1] = MFMA16(kf[kt][ks], vf1[ks], u[kt][1]); } }
#pragma unroll
            for (int ks = 0; ks < 4; ++ks) { d0 = MFMA16(qfr[ks], s0f[ks], d0); d1 = MFMA16(qfr[ks], s1f[ks], d1); }
            SCHED_FENCE();
            if (c > 0) HG_STORE(c - 1);
            ob[0][0] = pk2(d0[0], d0[1]); ob[0][1] = pk2(d0[2], d0[3]); ob[1][0] = pk2(d1[0], d1[1]); ob[1][1] = pk2(d1[2], d1[3]);
#pragma unroll
            for (int kt = 0; kt < 2; ++kt) { st[kt][0] = st[kt][0] * ev[kt] + u[kt][0] * ee[kt]; st[kt][1] = st[kt][1] * ev[kt] + u[kt][1] * ee[kt]; }
        }
        LDS_BARRIER();
        if (prod) {
            if (n < T / 64) {
                int lrow = 16 * j4 + r; asm volatile("" : "+v"(lrow));
                s16x8 qfr[4], kfr[4][4];
#pragma unroll
                for (int ks = 0; ks < 4; ++ks) qfr[ks] = ldfrag(HG_QM(bb), 16 * j4, 32 * ks, lane);
#pragma unroll
                for (int si = 0; si < 4; ++si)
#pragma unroll
                    for (int ks = 0; ks < 4; ++ks) kfr[si][ks] = ldfrag(HG_KM(bb), 16 * si, 32 * ks, lane);
                SCHED_FENCE();
                f32x4 d[4];
#pragma unroll
                for (int si = 0; si < 4; ++si) d[si] = (f32x4){0.f, 0.f, 0.f, 0.f};
#pragma unroll
                for (int ks = 0; ks < 4; ++ks)
#pragma unroll
                    for (int si = 0; si < 4; ++si) d[si] = MFMA16(kfr[si][ks], qfr[ks], d[si]);
                SCHED_FENCE();
#pragma unroll
                for (int si = 0; si < 4; ++si) { const int s0 = 16 * si + 4 * q; float v[4];
#pragma unroll
                    for (int i = 0; i < 4; ++i) v[i] = (s0 + i <= lrow) ? d[si][i] : 0.f;
                    v2u o; o.x = pk2(v[0], v[1]); o.y = pk2(v[2], v[3]); *(LAS v2u*)(HG_P(bb) + lrow * LQ + s0) = o; }
            }
        } else if (c >= 0) {
            const LAS float* vn_ = HG_VEC(bb);
#pragma unroll
            for (int kt = 0; kt < 2; ++kt) { const f32x4 en = (n < T / 64) ? *(const LAS f32x4*)(vn_ + 16 * (2 * j4 + kt) + 4 * q) : (f32x4){1.f, 1.f, 1.f, 1.f};
#pragma unroll
                for (int dvt = 0; dvt < 2; ++dvt) { const f32x4 sv = st[kt][dvt] * en; v2u o; o.x = pk2(sv[0], sv[1]); o.y = pk2(sv[2], sv[3]);
                    *(LAS v2u*)(ST + (16 * dvt + r) * LP + 16 * (2 * j4 + kt) + 4 * q) = o; } }
        }
        LDS_BARRIER();
    }
    if (!prod) HG_STORE(T / 64 - 1);
#undef HG_STORE
#undef HG_LOAD
#undef HG_QM
#undef HG_KM
#undef HG_P
#undef HG_V
#undef HG_VEC
}

__device__ __forceinline__ void phase_post(const Args& a, unsigned char* ws, int l, int gw, int NGW, int lane) {
    bf16* PROJ = (bf16*)(ws + WS_PROJ); const bf16* SCR = (const bf16*)(ws + WS_SCR);
    const int c0 = lane * 8;
    {
        float snw0[8], snw1[8];
        { const float* p = a.in[I_SNW] + l * 1024;
#pragma unroll
          for (int e = 0; e < 8; ++e) { snw0[e] = p[c0 + e]; snw1[e] = p[512 + c0 + e]; } }
        for (int t = gw; t < M; t += 4 * NGW) {
            v4u ry0[4], rz0[4], ry1[4], rz1[4];
#pragma unroll
            for (int u = 0; u < 4; ++u) { const int tt = (t + u * NGW < M) ? t + u * NGW : t; const bf16* base = PROJ + (size_t)tt * PJ;
                ry0[u] = *(const GAS v4u*)(base + C_SX + c0); rz0[u] = *(const GAS v4u*)(base + C_SZ + c0); ry1[u] = *(const GAS v4u*)(base + C_SX + 512 + c0); rz1[u] = *(const GAS v4u*)(base + C_SZ + 512 + c0); }
#pragma unroll
            for (int u = 0; u < 4; ++u) { if (t + u * NGW < M) { bf16* base = PROJ + (size_t)(t + u * NGW) * PJ;
                float y0[8], z0[8], y1[8], z1[8]; unpack8(ry0[u], y0); unpack8(rz0[u], z0); unpack8(ry1[u], y1); unpack8(rz1[u], z1);
                float s0 = 0.f, s1 = 0.f;
#pragma unroll
                for (int e = 0; e < 8; ++e) { y0[e] *= siluf(z0[e]); y1[e] *= siluf(z1[e]); s0 += y0[e] * y0[e]; s1 += y1[e] * y1[e]; }
                const float r0 = __builtin_amdgcn_rsqf(wave_sum(s0) * (1.f / 512.f) + EPS), r1 = __builtin_amdgcn_rsqf(wave_sum(s1) * (1.f / 512.f) + EPS);
#pragma unroll
                for (int e = 0; e < 8; ++e) { y0[e] *= r0 * snw0[e]; y1[e] *= r1 * snw1[e]; }
                *(GAS v4u*)(base + C_SZ + c0) = pack8(y0); *(GAS v4u*)(base + C_SZ + 512 + c0) = pack8(y1); } }
        }
    }
    {
        float mnw[8], msk[8], cw[4][8], cbb[8];
#pragma unroll
        for (int e = 0; e < 8; ++e) { mnw[e] = a.in[I_MNW][l * 512 + c0 + e]; msk[e] = a.in[I_MSKIP][l * 512 + c0 + e]; cbb[e] = a.in[I_MCB][l * 512 + c0 + e];
#pragma unroll
            for (int j = 0; j < 4; ++j) cw[j][e] = a.in[I_MCW][(l * 4 + j) * 512 + c0 + e]; }
        for (int t = gw; t < M; t += 2 * NGW) {
            v4u rh[2], ro[2], rzz[2], rx[2][4];
#pragma unroll
            for (int u = 0; u < 2; ++u) { const int tt = (t + u * NGW < M) ? t + u * NGW : t; const bf16* base = PROJ + (size_t)tt * PJ; const int tl = tt % T;
                rh[u] = *(const GAS v4u*)(SCR + (size_t)tt * 1024 + c0); ro[u] = *(const GAS v4u*)(base + C_MO + c0); rzz[u] = *(const GAS v4u*)(base + C_MZ + c0);
#pragma unroll
                for (int j = 0; j < 4; ++j) rx[u][j] = (tl - 3 + j >= 0) ? *(const GAS v4u*)(PROJ + (size_t)(tt - 3 + j) * PJ + C_MX + c0) : (v4u){0u, 0u, 0u, 0u}; }
#pragma unroll
            for (int u = 0; u < 2; ++u) { if (t + u * NGW < M) { bf16* base = PROJ + (size_t)(t + u * NGW) * PJ;
                float hr[8], mo[8], mz[8]; unpack8(rh[u], hr); unpack8(ro[u], mo); unpack8(rzz[u], mz);
                float s = 0.f;
#pragma unroll
                for (int e = 0; e < 8; ++e) s += hr[e];
                s += __shfl_xor(s, 1); s += __shfl_xor(s, 2); s += __shfl_xor(s, 4); s += __shfl_xor(s, 8);
                const float mu = s * (1.f / 128.f); float q = 0.f;
#pragma unroll
                for (int e = 0; e < 8; ++e) { hr[e] -= mu; q += hr[e] * hr[e]; }
                q += __shfl_xor(q, 1); q += __shfl_xor(q, 2); q += __shfl_xor(q, 4); q += __shfl_xor(q, 8);
                const float rstd = __builtin_amdgcn_rsqf(q * (1.f / 128.f) + EPS);
                float mc[8];
#pragma unroll
                for (int e = 0; e < 8; ++e) mc[e] = cbb[e];
#pragma unroll
                for (int j = 0; j < 4; ++j) { float xj[8]; unpack8(rx[u][j], xj);
#pragma unroll
                    for (int e = 0; e < 8; ++e) mc[e] += cw[j][e] * xj[e]; }
                float y[8];
#pragma unroll
                for (int e = 0; e < 8; ++e) y[e] = (hr[e] * rstd * mnw[e] * sigm(mo[e]) + msk[e] * siluf(mc[e])) * siluf(mz[e]);
                *(GAS v4u*)(base + C_MZ + c0) = pack8(y); } }
        }
    }
    {
        float hnw[8];
#pragma unroll
        for (int e = 0; e < 8; ++e) hnw[e] = a.in[I_HNW][l * 512 + c0 + e];
        for (int t = gw; t < M; t += 4 * NGW) {
            v4u rr[4], rg[4];
#pragma unroll
            for (int u = 0; u < 4; ++u) { const int tt = (t + u * NGW < M) ? t + u * NGW : t; rr[u] = *(const GAS v4u*)(PROJ + (size_t)tt * PJ + C_GI + c0); rg[u] = *(const GAS v4u*)(PROJ + (size_t)tt * PJ + C_GZ + c0); }
#pragma unroll
            for (int u = 0; u < 4; ++u) { if (t + u * NGW < M) { float o[8], gz[8]; unpack8(rr[u], o); unpack8(rg[u], gz);
                float q = 0.f;
#pragma unroll
                for (int e = 0; e < 8; ++e) q += o[e] * o[e];
                q += __shfl_xor(q, 1); q += __shfl_xor(q, 2); q += __shfl_xor(q, 4); q += __shfl_xor(q, 8);
                const float rstd = __builtin_amdgcn_rsqf(q * (1.f / 128.f) + EPS);
#pragma unroll
                for (int e = 0; e < 8; ++e) o[e] = o[e] * rstd * hnw[e] * siluf(gz[e]);
                *(GAS v4u*)(PROJ + (size_t)(t + u * NGW) * PJ + C_GZ + c0) = pack8(o); } }
        }
    }
}
__device__ __forceinline__ void phase_final(float* X, const float* w, int gw, int NGW, int lane) {
    for (int m = gw; m < M; m += NGW) {
        GAS f32x4* xr = (GAS f32x4*)(X + (size_t)m * D) + lane; const GAS f32x4* wr = (const GAS f32x4*)w + lane;
        f32x4 v[4]; float s = 0.f;
#pragma unroll
        for (int j = 0; j < 4; ++j) { v[j] = xr[64 * j]; s += (v[j].x * v[j].x + v[j].y * v[j].y) + (v[j].z * v[j].z + v[j].w * v[j].w); }
        const float rstd = 1.0f / sqrtf(wave_sum(s) * (1.f / D) + EPS);
#pragma unroll
        for (int j = 0; j < 4; ++j) { const f32x4 ww = wr[64 * j]; xr[64 * j] = v[j] * rstd * ww; }
    }
}

constexpr int PH_PER_LAYER = 8, N_PHASES = DEPTH * PH_PER_LAYER + 1;
__device__ __forceinline__ unsigned char* fresh_ws() {
    typedef __attribute__((address_space(4))) const char cchar4;
    cchar4* ka = (cchar4*)__builtin_amdgcn_kernarg_segment_ptr();
    const unsigned long long raw_ = *(volatile __attribute__((address_space(4))) const unsigned long long*)(ka + __builtin_offsetof(Args, ws));
    return (unsigned char*)((__attribute__((address_space(1))) unsigned char*)raw_);
}
struct Ctx { int tid, lane, wave, G, bx, gw, NGW; };
template <int SUB>
__device__ __forceinline__ void run_phase(const Args& args, const int l, LAS unsigned char* lds, const Ctx c0, const int imask = 7) {
    Ctx c = c0; { int t_ = threadIdx.x; asm volatile("" : "+v"(t_)); c.tid = t_; c.lane = t_ & 63; }
    unsigned char* ws = fresh_ws();
    bf16* XN = (bf16*)(ws + WS_XN); bf16* PROJ = (bf16*)(ws + WS_PROJ);
    const float* Xin = (l == 0) ? args.in[I_X] : args.out;
    if constexpr (SUB == 8) {
        if (c.G != 256) phase_final(args.out, args.in[I_FNW], c.gw, c.NGW, c.lane);
    } else if constexpr (SUB == 0) {
        phase_weights(args, ws, l, lds, c.gw, c.NGW, c.wave, c.lane);
        if (l == 0 || c.G != 256) phase_norm(Xin, args.in[I_NORMW] + l * D, XN, c.gw, c.NGW, c.lane);
    } else if constexpr (SUB == 1) {
        pg8::Gemm g{XN, (const bf16*)(ws + WS_W1), D, D}; pg8::StaticOrder S; S.init(M, PJ, D, c.G, c.bx);
        pg8::EpiProj E{PROJ, PJ, (bf16*)(ws + WS_HALO), HALO_COLS, 0};
        pg8::gemm_phase<pg8::EpiProj, pg8::StaticOrder, true, true>(lds, g, S, E);
    } else if constexpr (SUB == 2) {
        for (int tile = c.bx; tile < M / 64; tile += c.G) phase_c0(args, ws, l, lds, tile, c.tid);
    } else if constexpr (SUB >= 10 && SUB <= 12) {
        for (int it = c.bx; it < 256; it += c.G) {
            if (SUB == 10 && it < 128) scan_ssd(args, ws, l, lds, it >> 5, (it >> 1) & 15, it & 1, c.tid);
            else if (SUB == 11 && it >= 128 && it < 192) scan_ml(args, ws, l, lds, (it - 128) >> 4, ((it - 128) >> 2) & 3, (it - 128) & 3, c.tid);
            else if (SUB == 12 && it >= 192) scan_hg(args, ws, l, lds, (it - 192) >> 4, ((it - 192) >> 2) & 3, (it - 192) & 3, c.tid);
        }
    } else if constexpr (SUB == 13) {
        phase_post(args, ws, l, c.gw, c.NGW, c.lane);
    } else if constexpr (SUB == 14) {
        phase_norm(Xin, args.in[I_NORMW] + l * D, XN, c.gw, c.NGW, c.lane);
    } else if constexpr (SUB == 3) {
        for (int u = c.bx; u < 256; u += c.G) {
            const int xcd = u & 7, slot = u >> 3;
            if (slot < 16) { if (imask & 1) scan_ssd(args, ws, l, lds, xcd >> 1, (xcd & 1) * 8 + (slot >> 1), slot & 1, c.tid); }
            else if (slot < 24) { const int gi = xcd * 2 + ((slot - 16) >> 2); if (imask & 2) scan_ml(args, ws, l, lds, gi >> 2, gi & 3, slot & 3, c.tid); }
            else { const int gi = xcd * 2 + ((slot - 24) >> 2); if (imask & 4) scan_hg(args, ws, l, lds, gi >> 2, gi & 3, slot & 3, c.tid); }
        }
    } else if constexpr (SUB == 4) {
        if (imask & 1) phase_post(args, ws, l, c.gw, c.NGW, c.lane);
        if (imask & 2) phase_norm(Xin, args.in[I_NORMW] + l * D, XN, c.gw, c.NGW, c.lane);
    } else if constexpr (SUB == 5) {
        pg8::Gemm g{XN, (const bf16*)(ws + WS_W2), D, D}; pg8::StaticOrder S; S.init(M, 3072, D, c.G, c.bx);
        pg8::EpiProj E{PROJ, PJ, nullptr, 0, 1};
        pg8::gemm_phase<pg8::EpiProj, pg8::StaticOrder, true, true>(lds, g, S, E);
    } else if constexpr (SUB == 6) {
        pg8::Gemm g{PROJ + C_SZ, (const bf16*)(ws + WS_WBR), PJ, 2048}; pg8::BranchOrder S; S.init(M, D, c.G, c.bx);
        pg8::EpiMerge E{XN, D, PROJ, PJ};
        pg8::gemm_phase<pg8::EpiMerge, pg8::BranchOrder, true, true>(lds, g, S, E);
    } else if constexpr (SUB == 7) {
        pg8::Gemm g{XN, (const bf16*)(ws + WS_WOUT), D, D}; pg8::StaticOrder S; S.init(M, D, D, c.G, c.bx);
        {
            const bool last = (l == DEPTH - 1);
            pg8::EpiResidNorm E{Xin, args.out, D, last ? args.in[I_FNW] : args.in[I_NORMW] + (l + 1) * D, XN, (unsigned*)(ws + WS_XBUF) + (size_t)l * M * 4,
                                (unsigned*)(ws + WS_CTL) + CW_PANEL + l * 4096, last ? 1 : 0, EPS};
            pg8::gemm_phase<pg8::EpiResidNorm, pg8::StaticOrder, false, true>(lds, g, S, E);
        }
    }
}
__device__ __forceinline__ Ctx make_ctx() {
    Ctx c; c.tid = threadIdx.x; c.lane = c.tid & 63; c.wave = __builtin_amdgcn_readfirstlane(c.tid >> 6);
    c.G = gridDim.x; c.bx = blockIdx.x;
    const int vcu = (c.G % 8 == 0) ? (c.bx % 8) * (c.G / 8) + c.bx / 8 : c.bx;
    c.gw = vcu * NWAVES + c.wave; c.NGW = c.G * NWAVES; return c;
}
template <int SUB>
__global__ void __launch_bounds__(NTHR, 2) fwd_single(Args args, int l) {
    extern __shared__ __attribute__((aligned(16))) unsigned char lds_raw[];
    LAS unsigned char* lds = (LAS unsigned char*)lds_raw;
    const Ctx c = make_ctx();
    run_phase<SUB>(args, l, lds, c);
}
#if !MK_PER_PHASE
__global__ void __launch_bounds__(NTHR, 2) fwd_all(Args args) {
    extern __shared__ __attribute__((aligned(16))) unsigned char lds_raw[];
    LAS unsigned char* lds = (LAS unsigned char*)lds_raw;
    const Ctx c = make_ctx();
    volatile LAS unsigned* MISC = (volatile LAS unsigned*)(lds + MISC_OFF);
    if (c.tid < 32) MISC[c.tid] = 0u;
    __syncthreads();
    const XcdBarrier bar = xcd_barrier_post((unsigned*)(fresh_ws() + WS_CTL) + CW_BAR, MISC + 8);
#pragma unroll 1
    for (int it = 0; it < DEPTH + (PROBE_K > 0 ? 1 : 0); ++it) {
        const bool probe = (PROBE_K > 0) && it == 0;
        const int l = (PROBE_K > 0) ? (it == 0 ? 0 : it - 1) : it;
        const int kmax = probe ? PROBE_K : 8;
        const int im = probe ? PROBE_IMASK : 7;
        if (0 < kmax) { run_phase<0>(args, l, lds, c); xcd_barrier(bar); }
        if (1 < kmax) { run_phase<1>(args, l, lds, c); xcd_barrier(bar); }
        if (2 < kmax) { run_phase<2>(args, l, lds, c); xcd_barrier(bar); }
        if (3 < kmax) { run_phase<3>(args, l, lds, c, im); xcd_barrier(bar); }
        if (4 < kmax) { run_phase<4>(args, l, lds, c, im); xcd_barrier(bar); }
        if (5 < kmax) { run_phase<5>(args, l, lds, c); xcd_barrier(bar); }
        if (6 < kmax) { run_phase<6>(args, l, lds, c); xcd_barrier(bar); }
        if (7 < kmax) { run_phase<7>(args, l, lds, c); if (l + 1 < DEPTH || c.G != 256) xcd_barrier(bar); }
    }
    if constexpr ((FMASK >> 8) & 1) run_phase<8>(args, 0, lds, c);
}
#endif

template <int SUB> static void launch_single(int grid, hipStream_t stream, const Args& a, int l) {
    static bool attr_done = false;
    if (!attr_done) { (void)hipFuncSetAttribute((const void*)fwd_single<SUB>, hipFuncAttributeMaxDynamicSharedMemorySize, LDS_BYTES); attr_done = true; }
    hipLaunchKernelGGL(fwd_single<SUB>, dim3(grid), dim3(NTHR), LDS_BYTES, stream, a, l);
}
extern "C" void kernel_launch(void* const* d_in, const int* in_sizes, int n_in, void* d_out, int out_size, void* d_ws, size_t ws_size, hipStream_t stream) {
    static int grid = 0;
    if (grid == 0) {
        if (n_in != 25 || in_sizes[0] != M * D || out_size != M * D || ws_size < WS_END) { fprintf(stderr, "kernel_launch: unexpected shapes (n_in %d, in0 %d, out %d, ws %zu)\n", n_in, n_in > 0 ? in_sizes[0] : -1, out_size, ws_size); grid = -1; return; }
        int dev = 0, cus = 0;
        if (hipGetDevice(&dev) != hipSuccess || hipDeviceGetAttribute(&cus, hipDeviceAttributeMultiprocessorCount, dev) != hipSuccess) { grid = -1; return; }
#if !MK_PER_PHASE
        int per_cu = 0;
        if (hipFuncSetAttribute((const void*)fwd_all, hipFuncAttributeMaxDynamicSharedMemorySize, LDS_BYTES) != hipSuccess) { fprintf(stderr, "kernel_launch: hipFuncSetAttribute failed\n"); grid = -1; return; }
        if (hipOccupancyMaxActiveBlocksPerMultiprocessor(&per_cu, (const void*)fwd_all, NTHR, LDS_BYTES) != hipSuccess || per_cu < 1)
            fprintf(stderr, "kernel_launch: occupancy query reports %d workgroups per CU\n", per_cu);
#endif
        (void)hipGetLastError();
        grid = cus;
    }
    if (grid < 0) return;
    Args a{};
    for (int i = 0; i < 25; ++i) a.in[i] = (const float*)d_in[i];
    a.out = (float*)d_out; a.ws = (unsigned char*)d_ws; a.ph_lo = 0; a.ph_hi = N_PHASES;
#if MK_PER_PHASE
#if PROBE_K > 0
    launch_single<0>(grid, stream, a, 0);
#endif
#if PROBE_K > 1
    launch_single<1>(grid, stream, a, 0);
#endif
#if PROBE_K > 2
    launch_single<2>(grid, stream, a, 0);
#endif
#if PROBE_K > 3
    launch_single<PROBE_SCAN>(grid, stream, a, 0);
#endif
#if PROBE_K > 4
    launch_single<PROBE_POST>(grid, stream, a, 0);
#endif
#if PROBE_K > 5
    launch_single<5>(grid, stream, a, 0);
#endif
#if PROBE_K > 6
    launch_single<6>(grid, stream, a, 0);
#endif
    for (int l = 0; l < DEPTH; ++l) {
        launch_single<0>(grid, stream, a, l); launch_single<1>(grid, stream, a, l); launch_single<2>(grid, stream, a, l); launch_single<3>(grid, stream, a, l);
        launch_single<4>(grid, stream, a, l); launch_single<5>(grid, stream, a, l); launch_single<6>(grid, stream, a, l); launch_single<7>(grid, stream, a, l);
    }
    launch_single<8>(grid, stream, a, 0);
#else
    (void)hipMemsetAsync((char*)d_ws + WS_CTL, 0, CTL_ZERO_BYTES, stream);
    hipLaunchKernelGGL(fwd_all, dim3(grid), dim3(NTHR), LDS_BYTES, stream, a);
#endif
    const hipError_t le = hipPeekAtLastError();
    if (le != hipSuccess) fprintf(stderr, "kernel_launch: launch failed: %s\n", hipGetErrorName(le));
}
```

```cpp
#include <hip/hip_runtime.h>
#include <cstdio>
#include <cstdint>
#include <cmath>

#ifndef C0SKIP
#define C0SKIP 0
#endif
#ifndef PROBE_SCAN
#define PROBE_SCAN 3
#endif
#ifndef PROBE_POST
#define PROBE_POST 4
#endif
#ifndef PROBE_IMASK
#define PROBE_IMASK 7
#endif
#ifndef PROBE_K
#define PROBE_K 0
#endif
#ifndef FMASK
#define FMASK 0x1ff
#endif
#ifndef FUSED_UNROLL_LAYERS
#define FUSED_UNROLL_LAYERS 0
#endif
#ifndef MK_PER_PHASE
#define MK_PER_PHASE 0
#endif

namespace pg8 {
#define PG8_LAS __attribute__((address_space(3)))
typedef unsigned short bf16_t;
typedef short bf16x8 __attribute__((ext_vector_type(8)));
typedef float f32x4 __attribute__((ext_vector_type(4)));
typedef unsigned u32x4 __attribute__((ext_vector_type(4)));
constexpr int BM = 256, BK = 64, HALF = 128, HTB = HALF * BK * 2  , STAGE_BYTES = 8 * HTB, NXCD = 8, WGM = 8;

__host__ __device__ __forceinline__ int lds_byte(int r, int c) { const int st = (r >> 4) * 2 + (c >> 5), rr = r & 15, cc = c & 31, ob = rr * 64 + cc * 2; return st * 1024 + (ob ^ (((ob >> 9) & 1) << 5)); }
__host__ __device__ __forceinline__ void stage_rc(int b, int& R, int& C) { const int st = b / 1024, sb = b % 1024, swz = sb ^ (((sb >> 9) & 1) << 5); R = (st >> 1) * 16 + swz / 64; C = (st & 1) * 32 + (swz % 64) / 2; }
__host__ __device__ __forceinline__ int perm32(int rho) { const int n = rho >> 4, i = rho & 15; return 8 * (i >> 2) + 4 * n + (i & 3); }

struct Unit { int pm, pn, ka, kb, nt, tag; };
struct Gemm { const bf16_t* A; const bf16_t* Bt; int lda, ldb; };

struct StaticOrder {
    int nM, nN, nwg, G, c, nt;
    __host__ __device__ void init(int M, int N, int K, int G_, int c_) { nM = M / BM; nN = N / BM; nwg = nM * nN; G = G_; c = c_; nt = K / BK; }
    __host__ __device__ void map(int wgid, int& pm, int& pn) const {
        { const int q = nwg / NXCD, r = nwg % NXCD, xcd = wgid % NXCD, off = wgid / NXCD; wgid = (xcd < r ? xcd * (q + 1) : r * (q + 1) + (xcd - r) * q) + off; }
        const int nig = WGM * nN, gid = wgid / nig, fm = gid * WGM, gsz = (nM - fm) < WGM ? (nM - fm) : WGM;
        pm = fm + ((wgid % nig) % gsz); pn = (wgid % nig) / gsz;
    }
    __host__ __device__ bool next(int i, Unit& u) const {
        const long L = (long)i * G + c; if (L >= nwg) return false;
        map((int)L, u.pm, u.pn); u.ka = 0; u.kb = 0; u.nt = nt; u.tag = 0; return true;
    }
    __device__ __forceinline__ void a_ready(const Unit&) const {}
    __device__ __forceinline__ void done(const Unit&) const {}
};
struct BranchOrder {
    StaticOrder so;
    __host__ __device__ void init(int M, int N, int G_, int c_) { so.init(M, N, 1024, G_, c_); }
    __host__ __device__ bool next(int i, Unit& u) const {
        const int j = i / 3, br = i - 3 * j;
        const long L = (long)j * so.G + so.c; if (L >= so.nwg) return false;
        so.map((int)L, u.pm, u.pn);
        const int koff = br == 0 ? 0 : (br == 1 ? 1024 : 1536);
        u.ka = koff * 2; u.kb = koff * 2; u.nt = br == 0 ? 16 : 8; u.tag = br; return true;
    }
    __device__ __forceinline__ void a_ready(const Unit&) const {}
    __device__ __forceinline__ void done(const Unit&) const {}
};

typedef __bf16 pbf16x2 __attribute__((ext_vector_type(2)));
typedef float pf32x2 __attribute__((ext_vector_type(2)));
__device__ __forceinline__ unsigned cvt_pk_bf16(float lo, float hi) { const pf32x2 v = {lo, hi}; return __builtin_bit_cast(unsigned, __builtin_convertvector(v, pbf16x2)); }
__device__ __forceinline__ float bflo(unsigned w) { return __uint_as_float(w << 16); }
__device__ __forceinline__ float bfhi(unsigned w) { return __uint_as_float(w & 0xffff0000u); }
__device__ __forceinline__ float sigmoidf_(float x) { return __builtin_amdgcn_rcpf(1.0f + __expf(-x)); }

struct EpiProj {
    static constexpr bool PERM = true, AFTER_DRAIN = false;
    bf16_t* O; int ldc; bf16_t* halo; int halo_cols; int act;
    __device__ __forceinline__ void operator()(const f32x4 (&acc)[2][2][4][2], const Unit& u, int wr, int wc, int fr, int fq) const {
        const int row0 = u.pm * BM + wr * 64 + fr, col0 = u.pn * BM + wc * 32 + 8 * fq;
        const bool do_halo = halo != nullptr && (u.pn * BM < halo_cols) && fr >= 13;
#pragma unroll
        for (int ai = 0; ai < 2; ++ai)
#pragma unroll
            for (int m = 0; m < 4; ++m) { const int row = row0 + ai * HALF + m * 16; bf16_t* rowp = O + (size_t)row * ldc + col0;
#pragma unroll
                for (int bj = 0; bj < 2; ++bj) { f32x4 v0 = acc[ai][bj][m][0], v1 = acc[ai][bj][m][1];
                    if (act == 1) {
#pragma unroll
                        for (int e = 0; e < 4; ++e) { v0[e] = sigmoidf_(v0[e]); v1[e] = sigmoidf_(v1[e]); } }
                    u32x4 w; w.x = cvt_pk_bf16(v0[0], v0[1]); w.y = cvt_pk_bf16(v0[2], v0[3]); w.z = cvt_pk_bf16(v1[0], v1[1]); w.w = cvt_pk_bf16(v1[2], v1[3]);
                    *(u32x4*)(rowp + bj * HALF) = w;
                    if (m == 3 && do_halo) *(u32x4*)(halo + ((size_t)(row >> 6) * 3 + (fr - 13)) * halo_cols + col0 + bj * HALF) = w; } }
    }
};
struct EpiMerge {
    static constexpr bool PERM = true, AFTER_DRAIN = false;
    bf16_t* O; int ldc; const bf16_t* G; int ldg;
    __device__ __forceinline__ void operator()(const f32x4 (&acc)[2][2][4][2], const Unit& u, int wr, int wc, int fr, int fq) const {
        const int row0 = u.pm * BM + wr * 64 + fr, col0 = u.pn * BM + wc * 32 + 8 * fq;
#pragma unroll
        for (int ai = 0; ai < 2; ++ai)
#pragma unroll
            for (int mh = 0; mh < 2; ++mh) {
                u32x4 gq[2][2], pq[2][2];
#pragma unroll
                for (int m2 = 0; m2 < 2; ++m2) { const int row = row0 + ai * HALF + (2 * mh + m2) * 16;
#pragma unroll
                    for (int bj = 0; bj < 2; ++bj) { gq[m2][bj] = *(const u32x4*)(G + (size_t)row * ldg + u.tag * 1024 + col0 + bj * HALF);
                        pq[m2][bj] = (u.tag != 0) ? *(const u32x4*)(O + (size_t)row * ldc + col0 + bj * HALF) : (u32x4){0u, 0u, 0u, 0u}; } }
                asm volatile("" ::: "memory");
#pragma unroll
                for (int m2 = 0; m2 < 2; ++m2) { const int m = 2 * mh + m2; const int row = row0 + ai * HALF + m * 16; bf16_t* rowp = O + (size_t)row * ldc + col0;
#pragma unroll
                    for (int bj = 0; bj < 2; ++bj) { const f32x4 v0 = acc[ai][bj][m][0], v1 = acc[ai][bj][m][1];
                        const u32x4 g = gq[m2][bj], p = pq[m2][bj];
                        float o[8];
                        o[0] = bflo(p.x); o[1] = bfhi(p.x); o[2] = bflo(p.y); o[3] = bfhi(p.y); o[4] = bflo(p.z); o[5] = bfhi(p.z); o[6] = bflo(p.w); o[7] = bfhi(p.w);
                        o[0] += bflo(g.x) * v0[0]; o[1] += bfhi(g.x) * v0[1]; o[2] += bflo(g.y) * v0[2]; o[3] += bfhi(g.y) * v0[3];
                        o[4] += bflo(g.z) * v1[0]; o[5] += bfhi(g.z) * v1[1]; o[6] += bflo(g.w) * v1[2]; o[7] += bfhi(g.w) * v1[3];
                        u32x4 w; w.x = cvt_pk_bf16(o[0], o[1]); w.y = cvt_pk_bf16(o[2], o[3]); w.z = cvt_pk_bf16(o[4], o[5]); w.w = cvt_pk_bf16(o[6], o[7]);
                        *(u32x4*)(rowp + bj * HALF) = w; } }
            }
    }
};
struct EpiResid {
    static constexpr bool PERM = false, AFTER_DRAIN = false;
    const float* base; float* out; int ldc;
    __device__ __forceinline__ void operator()(const f32x4 (&acc)[2][2][4][2], const Unit& u, int wr, int wc, int fr, int fq) const {
        const int row0 = u.pm * BM + wr * 64 + fr, col0 = u.pn * BM + wc * 32 + 4 * fq;
#pragma unroll
        for (int ai = 0; ai < 2; ++ai)
#pragma unroll
            for (int mh = 0; mh < 2; ++mh) {
                f32x4 bs[2][2][2];
#pragma unroll
                for (int m2 = 0; m2 < 2; ++m2) { const size_t off = (size_t)(row0 + ai * HALF + (2 * mh + m2) * 16) * ldc + col0;
#pragma unroll
                    for (int bj = 0; bj < 2; ++bj)
#pragma unroll
                        for (int n = 0; n < 2; ++n) bs[m2][bj][n] = *(const f32x4*)(base + off + bj * HALF + n * 16); }
                asm volatile("" ::: "memory");
#pragma unroll
                for (int m2 = 0; m2 < 2; ++m2) { const size_t off = (size_t)(row0 + ai * HALF + (2 * mh + m2) * 16) * ldc + col0;
#pragma unroll
                    for (int bj = 0; bj < 2; ++bj)
#pragma unroll
                        for (int n = 0; n < 2; ++n) *(f32x4*)(out + off + bj * HALF + n * 16) = bs[m2][bj][n] + acc[ai][bj][2 * mh + m2][n]; }
            }
    }
};
struct EpiResidNorm {
    static constexpr bool PERM = false, AFTER_DRAIN = true;
    const float* base; float* out; int ldc; const float* w; bf16_t* xn; unsigned* xbuf; unsigned* cnt; int mode; float eps;
    __device__ __forceinline__ void fused(f32x4 (&acc)[2][2][4][2], const Unit& u, int wr, int wc, int fr, int fq, PG8_LAS unsigned char* lds, int wid, int lane) const {
        PG8_LAS float* P = (PG8_LAS float*)lds;
        PG8_LAS float* S = (PG8_LAS float*)(lds + 4096);
        int row0 = u.pm * BM + wr * 64 + fr, col0 = u.pn * BM + wc * 32 + 4 * fq;
        asm volatile("" : "+v"(row0), "+v"(col0));
#pragma unroll
        for (int ai = 0; ai < 2; ++ai)
#pragma unroll
            for (int m = 0; m < 4; ++m) {
                f32x4 bs[2][2]; const unsigned off = (unsigned)(row0 + ai * HALF + m * 16) * (unsigned)ldc + (unsigned)col0;
#pragma unroll
                for (int bj = 0; bj < 2; ++bj)
#pragma unroll
                    for (int n = 0; n < 2; ++n) bs[bj][n] = *(const f32x4*)(base + off + bj * HALF + n * 16);
#pragma unroll
                for (int bj = 0; bj < 2; ++bj)
#pragma unroll
                    for (int n = 0; n < 2; ++n) acc[ai][bj][m][n] += bs[bj][n];
                asm volatile("" : "+v"(acc[ai][0][m][0]), "+v"(acc[ai][0][m][1]), "+v"(acc[ai][1][m][0]), "+v"(acc[ai][1][m][1]) :: "memory");
            }
#pragma unroll
        for (int ai = 0; ai < 2; ++ai)
#pragma unroll
            for (int m = 0; m < 4; ++m) { float sq = 0.f;
#pragma unroll
                for (int bj = 0; bj < 2; ++bj)
#pragma unroll
                    for (int n = 0; n < 2; ++n) { const f32x4 x = acc[ai][bj][m][n]; sq += (x[0] * x[0] + x[1] * x[1]) + (x[2] * x[2] + x[3] * x[3]); }
                sq += __shfl_xor(sq, 16); sq += __shfl_xor(sq, 32);
                if (fq == 0) P[(ai * HALF + wr * 64 + m * 16 + fr) * 4 + wc] = sq; }
        asm volatile("s_waitcnt lgkmcnt(0)" ::: "memory"); __builtin_amdgcn_s_barrier(); asm volatile("" ::: "memory");
        const int row = wid * 32 + (lane & 31);
        if (lane < 32) { const float t = (P[row * 4 + 0] + P[row * 4 + 1]) + (P[row * 4 + 2] + P[row * 4 + 3]);
            __hip_atomic_store(xbuf + ((unsigned)(u.pm * BM + row) * 4u + (unsigned)u.pn), __float_as_uint(t), __ATOMIC_RELAXED, __HIP_MEMORY_SCOPE_AGENT); }
        asm volatile("s_waitcnt vmcnt(0)" ::: "memory");
        if (lane == 0) __hip_atomic_fetch_add(cnt + 64 * u.pm, 1u, __ATOMIC_RELAXED, __HIP_MEMORY_SCOPE_AGENT);
        if (wid == 0) { unsigned sp = 0u;
            while ((unsigned)__builtin_amdgcn_readfirstlane(__hip_atomic_load(cnt + 64 * u.pm, __ATOMIC_RELAXED, __HIP_MEMORY_SCOPE_AGENT)) < 32u) { __builtin_amdgcn_s_sleep(2); if (++sp > (1u << 22)) break; }
            __builtin_amdgcn_fence(__ATOMIC_ACQUIRE, "agent"); }
        asm volatile("s_waitcnt vmcnt(0) lgkmcnt(0)" ::: "memory"); __builtin_amdgcn_s_barrier(); asm volatile("" ::: "memory");
        if (lane < 32) { const unsigned* sl = xbuf + (unsigned)(u.pm * BM + row) * 4u; float t = 0.f;
#pragma unroll
            for (int k = 0; k < 4; ++k) t += __uint_as_float(__hip_atomic_load(sl + k, __ATOMIC_RELAXED, __HIP_MEMORY_SCOPE_AGENT));
            S[row] = __builtin_amdgcn_rsqf(t * (1.0f / 1024.0f) + eps); }
        asm volatile("s_waitcnt lgkmcnt(0)" ::: "memory"); __builtin_amdgcn_s_barrier(); asm volatile("" ::: "memory");
        f32x4 wv[2][2];
#pragma unroll
        for (int bj = 0; bj < 2; ++bj)
#pragma unroll
            for (int n = 0; n < 2; ++n) wv[bj][n] = *(const f32x4*)(w + col0 + bj * HALF + n * 16);
#pragma unroll
        for (int ai = 0; ai < 2; ++ai)
#pragma unroll
            for (int m = 0; m < 4; ++m) { const int r = ai * HALF + wr * 64 + m * 16 + fr; const float rs = S[r]; const unsigned off = (unsigned)(u.pm * BM + r) * (unsigned)ldc + (unsigned)col0;
#pragma unroll
                for (int bj = 0; bj < 2; ++bj)
#pragma unroll
                    for (int n = 0; n < 2; ++n) { const f32x4 x = acc[ai][bj][m][n]; const f32x4 y = x * rs * wv[bj][n];
                        if (mode == 1) *(f32x4*)(out + off + bj * HALF + n * 16) = y;
                        else { *(f32x4*)(out + off + bj * HALF + n * 16) = x;
                            typedef unsigned u32x2v __attribute__((ext_vector_type(2))); u32x2v pkd; pkd.x = cvt_pk_bf16(y[0], y[1]); pkd.y = cvt_pk_bf16(y[2], y[3]);
                            *(u32x2v*)(xn + off + bj * HALF + n * 16) = pkd; } } }
    }
};

template <class Epi, class Sched, bool ALIGN_EPI = false, bool SP2 = false>
__device__ __forceinline__ void gemm_phase(PG8_LAS unsigned char* lds, const Gemm g, const Sched& S, const Epi& E) {
    int tid_ = threadIdx.x; asm volatile("" : "+v"(tid_));
    const int tid = tid_, wid = __builtin_amdgcn_readfirstlane(tid >> 6), lane = tid & 63, wr = wid >> 2, wc = wid & 3, fr = lane & 15, fq = lane >> 4;
    const int lda = g.lda, ldb = g.ldb;
    unsigned voffA[2], voffB[2];
#pragma unroll
    for (int i = 0; i < 2; ++i) { int R, C; stage_rc(tid * 16 + i * 8192, R, C); const int Rb = Epi::PERM ? ((R & ~31) + perm32(R & 31)) : R;
        voffA[i] = (unsigned)(R * lda + C) * 2u; voffB[i] = (unsigned)(Rb * ldb + C) * 2u; }
    const size_t kstep = (size_t)(BK * 2);
    const size_t hstepA = (size_t)HALF * lda * 2, hstepB = (size_t)HALF * ldb * 2;
    const size_t tstepA = 2 * hstepA, tstepB = 2 * hstepB;
    const unsigned ldsw = (unsigned)wid * 1024u;
    const int aoff = lds_byte(wr * 64 + fr, fq * 8), boff = lds_byte(wc * 32 + fr, fq * 8);
#define PG8_SA(b, h) (((b) * 2 + (h)) * HTB)
#define PG8_SB(b, h) ((4 + (b) * 2 + (h)) * HTB)
#define PG8_STAGE(bufoff, gbase, voff) do { _Pragma("unroll") for (int _i = 0; _i < 2; ++_i) \
        __builtin_amdgcn_global_load_lds((const unsigned*)((const char*)(gbase) + (voff)[_i]), (PG8_LAS unsigned*)(lds + (bufoff) + ldsw + _i * 8192), 16, 0, 0); } while (0)
#define PG8_LDA(dst, b, h) do { _Pragma("unroll") for (int m = 0; m < 4; ++m) _Pragma("unroll") for (int k = 0; k < 2; ++k) dst[m][k] = *(const PG8_LAS bf16x8*)(lds + PG8_SA(b, h) + aoff + m * 2048 + k * 1024); } while (0)
#define PG8_LDB(dst, b, h) do { _Pragma("unroll") for (int n = 0; n < 2; ++n) _Pragma("unroll") for (int k = 0; k < 2; ++k) dst[n][k] = *(const PG8_LAS bf16x8*)(lds + PG8_SB(b, h) + boff + n * 2048 + k * 1024); } while (0)
#define PG8_MMA(ai, bj, At, Bt) do { __builtin_amdgcn_s_setprio(1); _Pragma("unroll") for (int m = 0; m < 4; ++m) _Pragma("unroll") for (int n = 0; n < 2; ++n) _Pragma("unroll") for (int k = 0; k < 2; ++k) \
        acc[ai][bj][m][n] = __builtin_amdgcn_mfma_f32_16x16x32_bf16(Bt[n][k], At[m][k], acc[ai][bj][m][n], 0, 0, 0); __builtin_amdgcn_s_setprio(0); } while (0)
#define PG8_WAIT_V(n) asm volatile("s_waitcnt vmcnt(" #n ")" ::: "memory")
#define PG8_WAIT_L(n) asm volatile("s_waitcnt lgkmcnt(" #n ")" ::: "memory")
#define PG8_BAR __builtin_amdgcn_s_barrier()
#define PG8_SCHED __builtin_amdgcn_sched_barrier(0)
    Unit cur, nxt; int ui = 0;
    if (!S.next(0, cur)) return;
    f32x4 acc[2][2][4][2];
#pragma unroll
    for (int a = 0; a < 2; ++a)
#pragma unroll
        for (int b = 0; b < 2; ++b)
#pragma unroll
            for (int m = 0; m < 4; ++m)
#pragma unroll
                for (int n = 0; n < 2; ++n) acc[a][b][m][n] = (f32x4){0.f, 0.f, 0.f, 0.f};
    bf16x8 At[4][2], B0[2][2], B1[2][2];
    const char* cA = (const char*)g.A + (size_t)cur.pm * tstepA + cur.ka; const char* cB = (const char*)g.Bt + (size_t)cur.pn * tstepB + cur.kb;
    S.a_ready(cur);
    if constexpr (SP2) {
        PG8_STAGE(PG8_SB(0, 0), cB, voffB); PG8_STAGE(PG8_SB(0, 1), cB + hstepB, voffB); PG8_STAGE(PG8_SA(0, 0), cA, voffA); PG8_STAGE(PG8_SA(0, 1), cA + hstepA, voffA);
        if (wr == 1) PG8_BAR;
        PG8_WAIT_V(2); PG8_BAR;
        PG8_STAGE(PG8_SB(1, 0), cB + kstep, voffB); PG8_STAGE(PG8_SA(1, 0), cA + kstep, voffA); PG8_STAGE(PG8_SB(1, 1), cB + hstepB + kstep, voffB);
        PG8_WAIT_V(6); PG8_BAR;
    } else {
        PG8_STAGE(PG8_SB(0, 0), cB, voffB); PG8_STAGE(PG8_SA(0, 0), cA, voffA); PG8_STAGE(PG8_SB(0, 1), cB + hstepB, voffB); PG8_STAGE(PG8_SA(0, 1), cA + hstepA, voffA);
        if (wr == 1) PG8_BAR;
        PG8_WAIT_V(4); PG8_BAR;
        PG8_STAGE(PG8_SB(1, 0), cB + kstep, voffB); PG8_STAGE(PG8_SA(1, 0), cA + kstep, voffA); PG8_STAGE(PG8_SB(1, 1), cB + hstepB + kstep, voffB);
        PG8_WAIT_V(6); PG8_BAR;
    }
    for (;;) {
        const bool has_next = S.next(ui + 1, nxt);
        const char* nA = has_next ? (const char*)g.A + (size_t)nxt.pm * tstepA + nxt.ka : cA; const char* nB = has_next ? (const char*)g.Bt + (size_t)nxt.pn * tstepB + nxt.kb : cB;
        const int nt = cur.nt;
        for (int t = 0; t < nt; t += 2) {
            const bool last = (t == nt - 2);
            const char* a1 = cA + (size_t)(t + 1) * kstep;
            const char* a2 = last ? nA : cA + (size_t)(t + 2) * kstep; const char* b2 = last ? nB : cB + (size_t)(t + 2) * kstep;
            const char* a3 = a2 + kstep; const char* b3 = b2 + kstep;
            if (last && has_next) S.a_ready(nxt);
            if constexpr (SP2) {
            PG8_LDB(B0, 0, 0); PG8_LDB(B1, 0, 1); PG8_SCHED; PG8_LDA(At, 0, 0); PG8_STAGE(PG8_SA(1, 1), a1 + hstepA, voffA);
            PG8_WAIT_V(8); PG8_WAIT_L(0); PG8_BAR; PG8_MMA(0, 0, At, B0); PG8_MMA(0, 1, At, B1); PG8_BAR; PG8_SCHED;
            PG8_LDA(At, 0, 1); PG8_STAGE(PG8_SB(0, 0), b2, voffB); PG8_STAGE(PG8_SB(0, 1), b2 + hstepB, voffB); PG8_STAGE(PG8_SA(0, 0), a2, voffA);
            PG8_WAIT_V(8); PG8_WAIT_L(0); PG8_BAR; PG8_MMA(1, 0, At, B0); PG8_MMA(1, 1, At, B1); PG8_BAR; PG8_SCHED;
            PG8_LDB(B0, 1, 0); PG8_LDB(B1, 1, 1); PG8_SCHED; PG8_LDA(At, 1, 0); PG8_STAGE(PG8_SA(0, 1), a2 + hstepA, voffA);
            PG8_WAIT_V(8); PG8_WAIT_L(0); PG8_BAR; PG8_MMA(0, 0, At, B0); PG8_MMA(0, 1, At, B1); PG8_BAR; PG8_SCHED;
            PG8_LDA(At, 1, 1); PG8_STAGE(PG8_SB(1, 0), b3, voffB); PG8_STAGE(PG8_SB(1, 1), b3 + hstepB, voffB); PG8_STAGE(PG8_SA(1, 0), a3, voffA);
            PG8_WAIT_V(8); PG8_WAIT_L(0); PG8_BAR; PG8_MMA(1, 0, At, B0); PG8_MMA(1, 1, At, B1); PG8_BAR; PG8_SCHED;
            } else {
            PG8_LDB(B0, 0, 0); PG8_SCHED; PG8_LDA(At, 0, 0); PG8_STAGE(PG8_SA(1, 1), a1 + hstepA, voffA);
            PG8_WAIT_L(8); PG8_BAR; PG8_WAIT_L(0); PG8_MMA(0, 0, At, B0); PG8_BAR; PG8_SCHED;
            PG8_LDB(B1, 0, 1); PG8_STAGE(PG8_SB(0, 0), b2, voffB);
            PG8_BAR; PG8_WAIT_L(0); PG8_MMA(0, 1, At, B1); PG8_BAR;
            PG8_LDA(At, 0, 1); PG8_STAGE(PG8_SA(0, 0), a2, voffA);
            PG8_BAR; PG8_WAIT_L(0); PG8_MMA(1, 0, At, B0); PG8_BAR; PG8_SCHED;
            PG8_STAGE(PG8_SB(0, 1), b2 + hstepB, voffB);
            PG8_WAIT_V(6); PG8_BAR; PG8_MMA(1, 1, At, B1); PG8_BAR;
            PG8_LDB(B0, 1, 0); PG8_SCHED; PG8_LDA(At, 1, 0); PG8_STAGE(PG8_SA(0, 1), a2 + hstepA, voffA);
            PG8_WAIT_L(8); PG8_BAR; PG8_WAIT_L(0); PG8_MMA(0, 0, At, B0); PG8_BAR; PG8_SCHED;
            PG8_LDB(B1, 1, 1); PG8_STAGE(PG8_SB(1, 0), b3, voffB);
            PG8_BAR; PG8_WAIT_L(0); PG8_MMA(0, 1, At, B1); PG8_BAR;
            PG8_LDA(At, 1, 1); PG8_STAGE(PG8_SA(1, 0), a3, voffA);
            PG8_BAR; PG8_WAIT_L(0); PG8_MMA(1, 0, At, B0); PG8_BAR; PG8_SCHED;
            PG8_STAGE(PG8_SB(1, 1), b3 + hstepB, voffB);
            PG8_WAIT_V(6); PG8_BAR; PG8_MMA(1, 1, At, B1); PG8_BAR;
            }
        }
        if constexpr (ALIGN_EPI) { if (wr == 0) PG8_BAR; }
        if constexpr (!Epi::AFTER_DRAIN) { E(acc, cur, wr, wc, fr, fq); S.done(cur); }
        if (!has_next) break;
#pragma unroll
        for (int a = 0; a < 2; ++a)
#pragma unroll
            for (int b = 0; b < 2; ++b)
#pragma unroll
                for (int m = 0; m < 4; ++m)
#pragma unroll
                    for (int n = 0; n < 2; ++n) acc[a][b][m][n] = (f32x4){0.f, 0.f, 0.f, 0.f};
        cur = nxt; cA = nA; cB = nB; ++ui;
        if constexpr (ALIGN_EPI) { if (wr == 1) PG8_BAR; }
    }
    PG8_WAIT_V(0);
    if constexpr (!ALIGN_EPI) { if (wr == 0) PG8_BAR; }
    PG8_BAR;
    if constexpr (Epi::AFTER_DRAIN) { E.fused(acc, cur, wr, wc, fr, fq, lds, wid, lane); S.done(cur); }
#undef PG8_SA
#undef PG8_SB
#undef PG8_STAGE
#undef PG8_LDA
#undef PG8_LDB
#undef PG8_MMA
#undef PG8_WAIT_V
#undef PG8_WAIT_L
#undef PG8_BAR
#undef PG8_SCHED
}
}

constexpr int NWAVES = 8, NTHR = 512;
constexpr int BATCH = 4, T = 4096, D = 1024, M = BATCH * T, DEPTH = 2;
constexpr int N_IN = 9232;
constexpr float EPS = 1e-6f;
constexpr int PJ = 6144;
constexpr int C_SX = 0, C_SB = 1024, C_SC = 1280, C_MX = 1536, C_MO = 2048, C_GQ = 2560, C_GF = 3072, C_GI = 3584, C_SZ = 4096, C_MZ = 5120, C_GZ = 5632;
constexpr int HALO_COLS = 1536;
constexpr int O_SX = 0, O_SB = 1024, O_SC = 1280, O_DT = 1536, O_SZ = 1552, O_MX = 2576, O_MO = 3088, O_MZ = 3600, O_GQ = 4112, O_GF = 4624, O_GI = 5136, O_GZ = 5648, O_GATE = 6160;
__host__ __device__ __forceinline__ int orig_col(int n) {
    if (n < 1536) return n;
    if (n < 2048) return O_MX + (n - 1536);
    if (n < 2560) return O_MO + (n - 2048);
    if (n < 3072) return O_GQ + (n - 2560);
    if (n < 3584) return O_GF + (n - 3072);
    if (n < 4096) return O_GI + (n - 3584);
    if (n < 5120) return O_SZ + (n - 4096);
    if (n < 5632) return O_MZ + (n - 5120);
    return O_GZ + (n - 5632);
}
constexpr size_t MiB = 1u << 20;
constexpr size_t WS_CTL = 0, CTL_ZERO_BYTES = 64 * 1024;
constexpr size_t WS_W1 = 1 * MiB;
constexpr size_t WS_W2 = 13 * MiB;
constexpr size_t WS_WBR = 19 * MiB;
constexpr size_t WS_WOUT = 23 * MiB;
constexpr size_t WS_WDT = 25 * MiB;
constexpr size_t WS_WQKV = 25 * MiB + 64 * 1024;
constexpr size_t WS_HALO = 26 * MiB;
constexpr size_t WS_XBUF = 28 * MiB + 512 * 1024;
constexpr size_t WS_SC64A = 64 * 1024;
constexpr size_t WS_SC64B = 25 * MiB + 512 * 1024;
constexpr size_t WS_MLC = 64 * 1024 + 512 * 1024;
constexpr size_t WS_MLP = 28 * MiB + 256 * 1024;
constexpr size_t WS_DT = 29 * MiB;
constexpr size_t WS_IF = 30 * MiB;
constexpr size_t WS_HGV = 30 * MiB + 512 * 1024;
constexpr size_t WS_XN = 32 * MiB;
constexpr size_t WS_SCR = 64 * MiB;
constexpr size_t WS_PROJ = 96 * MiB;
constexpr size_t WS_END = 288 * MiB;
constexpr int CW_PANEL = 8192;
constexpr int CW_BAR = 1024;

constexpr int LDS_BYTES = 163840;
constexpr int MISC_OFF = 159744;

#define GAS __attribute__((address_space(1)))
#define LAS __attribute__((address_space(3)))
typedef unsigned short bf16;
typedef unsigned v4u __attribute__((ext_vector_type(4)));
typedef unsigned v2u __attribute__((ext_vector_type(2)));
typedef float f32x4 __attribute__((ext_vector_type(4)));
#define LDS_WAIT() asm volatile("s_waitcnt lgkmcnt(0)" ::: "memory")
#define LDS_BARRIER() do { asm volatile("s_waitcnt lgkmcnt(0)" ::: "memory"); __builtin_amdgcn_s_barrier(); asm volatile("" ::: "memory"); } while (0)
#define VM_WAIT() asm volatile("s_waitcnt vmcnt(0)" ::: "memory")
#define SCHED_FENCE() __builtin_amdgcn_sched_barrier(0)
typedef __bf16 hbf16x2 __attribute__((ext_vector_type(2)));
typedef float hf32x2 __attribute__((ext_vector_type(2)));
__device__ __forceinline__ unsigned pk2(float lo, float hi) { const hf32x2 v = {lo, hi}; return __builtin_bit_cast(unsigned, __builtin_convertvector(v, hbf16x2)); }
__device__ __forceinline__ unsigned f2bf(float f) { return pk2(f, 0.f) & 0xffffu; }
__device__ __forceinline__ float bf2f(unsigned short h) { return __uint_as_float((unsigned)h << 16); }
__device__ __forceinline__ float blo(unsigned w) { return __uint_as_float(w << 16); }
__device__ __forceinline__ float bhi(unsigned w) { return __uint_as_float(w & 0xffff0000u); }
__device__ __forceinline__ void unpack8(const v4u w, float (&f)[8]) { f[0] = blo(w.x); f[1] = bhi(w.x); f[2] = blo(w.y); f[3] = bhi(w.y); f[4] = blo(w.z); f[5] = bhi(w.z); f[6] = blo(w.w); f[7] = bhi(w.w); }
__device__ __forceinline__ v4u pack8(const float (&f)[8]) { v4u w; w.x = pk2(f[0], f[1]); w.y = pk2(f[2], f[3]); w.z = pk2(f[4], f[5]); w.w = pk2(f[6], f[7]); return w; }
__device__ __forceinline__ float sigm(float x) { return __builtin_amdgcn_rcpf(1.0f + __expf(-x)); }
__device__ __forceinline__ float siluf(float x) { return x * __builtin_amdgcn_rcpf(1.0f + __expf(-x)); }
__device__ __forceinline__ float softplusf(float x) { return x > 20.f ? x : log1pf(__expf(x)); }
__device__ __forceinline__ float logsigmoidf(float x) { return x < 0.f ? x - log1pf(__expf(x)) : -log1pf(__expf(-x)); }
__device__ __forceinline__ float wave_sum(float v) {
#pragma unroll
    for (int o = 1; o < 64; o <<= 1) v += __shfl_xor(v, o);
    return v;
}

#define XB_TMO      128
#define XB_XCNT(j)  (256  + 64 * (j))
#define XB_XSUB(j)  (1280 + 64 * (j))
#define XB_XGEN(j)  (2304 + 64 * (j))
#define XB_TOP      3328
#define XB_TOPGEN   3392
#define XCD_BAR_WORDS 3456
#define XB_SPIN_CAP (1u << 20)
__device__ __forceinline__ unsigned xb_ld(unsigned* p)              { return __hip_atomic_load(p, __ATOMIC_RELAXED, __HIP_MEMORY_SCOPE_AGENT); }
__device__ __forceinline__ unsigned xb_add(unsigned* p, unsigned v) { return __hip_atomic_fetch_add(p, v, __ATOMIC_RELAXED, __HIP_MEMORY_SCOPE_AGENT); }
__device__ __forceinline__ unsigned xb_xcc_id() { return (unsigned)__builtin_amdgcn_s_getreg((3 << 11) | 20) & 0xFu; }
#define XB_SPIN(cond, bar) do { unsigned _sp = 0; while (cond) { __builtin_amdgcn_s_sleep(1); \
    if ((++_sp & 255u) == 0u) { if (xb_ld(&(bar)[XB_TMO])) break; if (_sp > XB_SPIN_CAP) { atomicAdd(&(bar)[XB_TMO], 1u); break; } } } } while (0)
struct XcdBarrier { unsigned* bar; unsigned x; volatile LAS unsigned* st; };
__device__ __forceinline__ XcdBarrier xcd_barrier_post(unsigned* bar, volatile LAS unsigned* st) {
    XcdBarrier b; b.bar = bar; b.x = xb_xcc_id(); b.st = st;
    if (threadIdx.x == 0) (void)xb_add(&bar[XB_XCNT(b.x)], 1u);
    return b;
}
__device__ __forceinline__ void xcd_barrier_complete(unsigned* bar, unsigned x, unsigned& nloc, unsigned& nx) {
    const unsigned G = gridDim.x * gridDim.y * gridDim.z;
    unsigned sum, cnt, mine, sp = 0u;
    for (;;) {
        sum = 0u; cnt = 0u; mine = 0u;
#pragma unroll
        for (unsigned j = 0; j < 16; ++j) { const unsigned c = xb_ld(&bar[XB_XCNT(j)]); sum += c; cnt += (c > 0u) ? 1u : 0u; mine = (j == x) ? c : mine; }
        if (sum == G) break;
        __builtin_amdgcn_s_sleep(1);
        if ((++sp & 255u) == 0u) { if (xb_ld(&bar[XB_TMO])) break; if (sp > XB_SPIN_CAP) { atomicAdd(&bar[XB_TMO], 1u); break; } }
    }
    nloc = mine > 0u ? mine : 1u; nx = cnt > 0u ? cnt : 1u;
}
__device__ __forceinline__ void xcd_barrier(const XcdBarrier& b) {
    asm volatile("s_waitcnt vmcnt(0)" ::: "memory");
    __syncthreads();
    if (threadIdx.x == 0) {
        unsigned long long pb_ = (unsigned long long)b.bar; asm volatile("" : "+v"(pb_));
        unsigned* bar = (unsigned*)pb_;
        __builtin_amdgcn_s_waitcnt(0);
        unsigned nloc = b.st[0], nx = b.st[1];
        if (nloc == 0u) { xcd_barrier_complete(bar, b.x, nloc, nx); b.st[0] = nloc; b.st[1] = nx; }
        const unsigned old = xb_add(&bar[XB_XSUB(b.x)], 1u);
        const unsigned gen = old / nloc;
        if (old + 1u == (gen + 1u) * nloc) {
            __builtin_amdgcn_fence(__ATOMIC_RELEASE, "agent");
            asm volatile("s_waitcnt vmcnt(0)" ::: "memory");
            const unsigned og = xb_add(&bar[XB_TOP], 1u);
            const unsigned tg = og / nx;
            if (og + 1u == (tg + 1u) * nx) xb_add(&bar[XB_TOPGEN], 1u);
            else XB_SPIN(xb_ld(&bar[XB_TOPGEN]) == tg, bar);
            __builtin_amdgcn_fence(__ATOMIC_ACQUIRE, "agent");
            xb_add(&bar[XB_XGEN(b.x)], 1u);
            asm volatile("s_waitcnt vmcnt(0)" ::: "memory");
        } else {
            XB_SPIN(xb_ld(&bar[XB_XGEN(b.x)]) == gen, bar);
            __builtin_amdgcn_fence(__ATOMIC_ACQUIRE, "agent");
            asm volatile("s_waitcnt vmcnt(0)" ::: "memory");
        }
    }
    __syncthreads();
}

struct Args { const float* in[25]; float* out; unsigned char* ws; int ph_lo, ph_hi; };
enum { I_X = 0, I_NORMW, I_WIN, I_SCW, I_SCB, I_DTB, I_ALOG, I_SD, I_SNW, I_MCW, I_MCB, I_WQ, I_WK, I_WV, I_WIF, I_BIF, I_MNW, I_MSKIP, I_HLB, I_HNW, I_WBS, I_WBM, I_WBH, I_WOUT, I_FNW };

__device__ __forceinline__ void transpose_item(const float* W, int ldw, int srcn0, int k0, bf16* WT, int ldt, int dstn0, int dstk0, LAS float* scr, int lane) {
#pragma unroll 8
    for (int i = 0; i < 32; ++i) { const int kk = 2 * i + (lane >> 5); scr[kk * 33 + (lane & 31)] = W[(size_t)(k0 + kk) * ldw + srcn0 + (lane & 31)]; }
    LDS_WAIT(); asm volatile("" ::: "memory");
    const int c = lane & 7;
#pragma unroll
    for (int j = 0; j < 4; ++j) { const int n = (lane >> 3) + 8 * j; const LAS float* s = scr + (8 * c) * 33 + n;
        v4u o; o.x = pk2(s[0 * 33], s[1 * 33]); o.y = pk2(s[2 * 33], s[3 * 33]); o.z = pk2(s[4 * 33], s[5 * 33]); o.w = pk2(s[6 * 33], s[7 * 33]);
        *(GAS v4u*)(WT + (size_t)(dstn0 + n) * ldt + dstk0 + k0 + 8 * c) = o; }
    LDS_WAIT(); asm volatile("" ::: "memory");
}
__device__ __forceinline__ void rms_row_to_bf16(const float* xrow, const float* w, bf16* orow, int lane) {
    const GAS f32x4* xr = (const GAS f32x4*)xrow + lane; const GAS f32x4* wr = (const GAS f32x4*)w + lane;
    f32x4 v[4]; float s = 0.f;
#pragma unroll
    for (int j = 0; j < 4; ++j) { v[j] = xr[64 * j]; s += (v[j].x * v[j].x + v[j].y * v[j].y) + (v[j].z * v[j].z + v[j].w * v[j].w); }
    const float rstd = 1.0f / sqrtf(wave_sum(s) * (1.f / D) + EPS);
    GAS v2u* o8 = (GAS v2u*)orow + lane;
#pragma unroll
    for (int j = 0; j < 4; ++j) { const f32x4 ww = wr[64 * j]; v2u o; o.x = pk2(v[j].x * rstd * ww.x, v[j].y * rstd * ww.y); o.y = pk2(v[j].z * rstd * ww.z, v[j].w * rstd * ww.w); o8[64 * j] = o; }
}
__device__ __forceinline__ void phase_norm(const float* X, const float* w, bf16* XN, int gw, int NGW, int lane) {
    const GAS f32x4* wr = (const GAS f32x4*)w + lane;
    f32x4 ww[4];
#pragma unroll
    for (int j = 0; j < 4; ++j) ww[j] = wr[64 * j];
    for (int m = gw; m < M; m += 4 * NGW) {
        f32x4 v[4][4];
#pragma unroll
        for (int u = 0; u < 4; ++u) { const int mm = (m + u * NGW < M) ? m + u * NGW : m; const GAS f32x4* xr = (const GAS f32x4*)(X + (size_t)mm * D) + lane;
#pragma unroll
            for (int j = 0; j < 4; ++j) v[u][j] = xr[64 * j]; }
#pragma unroll
        for (int u = 0; u < 4; ++u) { if (m + u * NGW < M) { float s0 = 0.f;
#pragma unroll
            for (int j = 0; j < 4; ++j) s0 += (v[u][j].x * v[u][j].x + v[u][j].y * v[u][j].y) + (v[u][j].z * v[u][j].z + v[u][j].w * v[u][j].w);
            const float r0 = __builtin_amdgcn_rsqf(wave_sum(s0) * (1.f / D) + EPS);
            GAS v2u* o0 = (GAS v2u*)(XN + (size_t)(m + u * NGW) * D) + lane;
#pragma unroll
            for (int j = 0; j < 4; ++j) { v2u o; o.x = pk2(v[u][j].x * r0 * ww[j].x, v[u][j].y * r0 * ww[j].y); o.y = pk2(v[u][j].z * r0 * ww[j].z, v[u][j].w * r0 * ww[j].w); o0[64 * j] = o; } } }
    }
}
__device__ __forceinline__ void phase_weights(const Args& a, unsigned char* ws, int l, LAS unsigned char* lds, int gw, int NGW, int wave, int lane) {
    LAS float* scr = (LAS float*)(lds + wave * 16384);
    const float* w_in = a.in[I_WIN] + (size_t)l * D * N_IN;
    bf16* W1 = (bf16*)(ws + WS_W1); bf16* W2 = (bf16*)(ws + WS_W2); bf16* WBR = (bf16*)(ws + WS_WBR); bf16* WOUT = (bf16*)(ws + WS_WOUT); bf16* WQKV = (bf16*)(ws + WS_WQKV); bf16* WDT = (bf16*)(ws + WS_WDT);
    constexpr int I_1 = 16 * (PJ / 32), I_2 = 16 * (3072 / 32), I_BS = 16 * 32, I_BM = 8 * 32, I_BH = 8 * 32, I_O = 16 * 32, I_QKV = 3 * 4 * 2 * 4;
    constexpr int NITEMS = I_1 + I_2 + I_BS + I_BM + I_BH + I_O + I_QKV;
    for (int it = gw; it < NITEMS; it += NGW) {
        int r = it;
        const float* src; int ldw, srcn0, k0, ldt, dstn0, dstk0; bf16* dst;
        if (r < I_1) { const int nb = r % (PJ / 32), kb = r / (PJ / 32); src = w_in; ldw = N_IN; srcn0 = orig_col(nb * 32); k0 = kb * 64; dst = W1; ldt = D; dstn0 = nb * 32; dstk0 = 0; }
        else if ((r -= I_1) < I_2) { const int nb = r % 96, kb = r / 96; src = w_in; ldw = N_IN; srcn0 = O_GATE + nb * 32; k0 = kb * 64; dst = W2; ldt = D; dstn0 = nb * 32; dstk0 = 0; }
        else if ((r -= I_2) < I_BS) { const int nb = r % 32, kb = r / 32; src = a.in[I_WBS] + (size_t)l * 1024 * 1024; ldw = 1024; srcn0 = nb * 32; k0 = kb * 64; dst = WBR; ldt = 2048; dstn0 = nb * 32; dstk0 = 0; }
        else if ((r -= I_BS) < I_BM) { const int nb = r % 32, kb = r / 32; src = a.in[I_WBM] + (size_t)l * 512 * 1024; ldw = 1024; srcn0 = nb * 32; k0 = kb * 64; dst = WBR; ldt = 2048; dstn0 = nb * 32; dstk0 = 1024; }
        else if ((r -= I_BM) < I_BH) { const int nb = r % 32, kb = r / 32; src = a.in[I_WBH] + (size_t)l * 512 * 1024; ldw = 1024; srcn0 = nb * 32; k0 = kb * 64; dst = WBR; ldt = 2048; dstn0 = nb * 32; dstk0 = 1536; }
        else if ((r -= I_BH) < I_O) { const int nb = r % 32, kb = r / 32; src = a.in[I_WOUT] + (size_t)l * 1024 * 1024; ldw = 1024; srcn0 = nb * 32; k0 = kb * 64; dst = WOUT; ldt = 1024; dstn0 = nb * 32; dstk0 = 0; }
        else { r -= I_O; const int nb = r % 4, kb = (r / 4) % 2, h = (r / 8) % 4, which = r / 32;
            src = (which == 0 ? a.in[I_WQ] : (which == 1 ? a.in[I_WK] : a.in[I_WV])) + ((size_t)l * 4 + h) * 128 * 128; ldw = 128; srcn0 = nb * 32; k0 = kb * 64;
            dst = WQKV + ((size_t)which * 4 + h) * 128 * 128; ldt = 128; dstn0 = nb * 32; dstk0 = 0; }
        transpose_item(src, ldw, srcn0, k0, dst, ldt, dstn0, dstk0, scr, lane);
    }
    for (int g2 = gw; g2 < 16 * D / 64; g2 += NGW) { const int i = g2 * 64 + lane, h = i >> 10, k = i & (D - 1); WDT[i] = (bf16)f2bf(w_in[(size_t)k * N_IN + O_DT + h]); }
}

__device__ __forceinline__ float hg_lower_bound(const float* hlb, int l, int c) {
    float mx = hlb[c];
#pragma unroll
    for (int d = 1; d < DEPTH; ++d) mx = fmaxf(mx, hlb[d * 512 + c]);
    float sum = 0.f, part = 0.f;
#pragma unroll
    for (int d = 0; d < DEPTH; ++d) { const float e = __expf(hlb[d * 512 + c] - mx); sum += e; if (d >= 1 && d <= l) part += e; }
    return part / sum;
}
typedef short s16x8 __attribute__((ext_vector_type(8)));
#define MFMA16(a_, b_, c_) __builtin_amdgcn_mfma_f32_16x16x32_bf16((a_), (b_), (c_), 0, 0, 0)
constexpr int MP = 520;
__device__ __forceinline__ void phase_c0(const Args& a, unsigned char* ws, int l, LAS unsigned char* lds, int tile, int tid) {
    bf16* PROJ = (bf16*)(ws + WS_PROJ); bf16* XNQK = (bf16*)(ws + WS_XN); const bf16* HALO = (const bf16*)(ws + WS_HALO);
    const bf16* WDT = (const bf16*)(ws + WS_WDT); const bf16* WQKV = (const bf16*)(ws + WS_WQKV);
    float* DT = (float*)(ws + WS_DT); float* IFB = (float*)(ws + WS_IF); bf16* SCRV = (bf16*)(ws + WS_SCR);
    const int t0 = tile * 64;
    const int lane = tid & 63, w = tid >> 6, q = lane >> 4, r = lane & 15;
    {
        const int tw = w & 3, kh = w >> 2;
        const bf16* xrow = XNQK + (size_t)(t0 + 16 * tw + r) * D + kh * 512 + 8 * q;
        const bf16* wrow = WDT + (size_t)r * D + kh * 512 + 8 * q;
        f32x4 d = (f32x4){0.f, 0.f, 0.f, 0.f};
#pragma unroll 8
        for (int ks = 0; ks < 16; ++ks) d = MFMA16(*(const GAS s16x8*)(xrow + 32 * ks), *(const GAS s16x8*)(wrow + 32 * ks), d);
        LAS float* dtp = (LAS float*)lds;
#pragma unroll
        for (int i = 0; i < 4; ++i) dtp[(kh * 64 + 16 * tw + 4 * q + i) * 16 + r] = d[i];
        __syncthreads();
        const float* dtb = a.in[I_DTB] + l * 16;
#pragma unroll
        for (int o = tid; o < 1024; o += NTHR) { const float dv_ = softplusf(dtp[o] + dtp[1024 + o] + dtb[o & 15]); DT[(size_t)t0 * 16 + o] = dv_; dtp[2048 + o] = dv_; }
        __syncthreads();
        { float* sc64 = (float*)(ws + ((t0 < M / 2) ? WS_SC64A : WS_SC64B)) + (size_t)(t0 % (M / 2)) * 16;
#pragma unroll
          for (int hh = 0; hh < 2; ++hh) { const int h = 2 * w + hh; const float aneg = -__expf(a.in[I_ALOG][l * 16 + h]);
              float inc = dtp[2048 + lane * 16 + h] * aneg;
#pragma unroll
              for (int o = 1; o < 64; o <<= 1) { const float t = __shfl_up(inc, o); if (lane >= o) inc += t; }
              sc64[lane * 16 + h] = inc; } }
    }
    if (!(C0SKIP & 2)) {
        const float* cw = a.in[I_SCW] + (size_t)l * 4 * 1536; const float* cb = a.in[I_SCB] + (size_t)l * 1536;
        const bool seq_start = (t0 % T) == 0;
        const int strip = tid >> 5;
#pragma unroll 1
        for (int batch = 0; batch < 6; ++batch) {
            const int col = (32 * batch + (tid & 31)) * 8;
            v4u raw[7];
#pragma unroll
            for (int j = 0; j < 7; ++j) { const int r = 4 * strip - 3 + j;
                if (r >= 0) raw[j] = *(const GAS v4u*)(PROJ + (size_t)(t0 + r) * PJ + col);
                else if (seq_start) raw[j] = (v4u){0u, 0u, 0u, 0u};
                else raw[j] = *(const GAS v4u*)(HALO + ((size_t)(tile - 1) * 3 + (r + 3)) * HALO_COLS + col); }
            VM_WAIT(); __syncthreads();
            v4u outw[4];
#pragma unroll
            for (int wd = 0; wd < 4; ++wd) {
                float xl[7], xh[7];
#pragma unroll
                for (int j = 0; j < 7; ++j) { const unsigned u = raw[j][wd]; xl[j] = blo(u); xh[j] = bhi(u); }
                typedef float f32x2 __attribute__((ext_vector_type(2)));
                f32x2 wj[4];
#pragma unroll
                for (int j = 0; j < 4; ++j) wj[j] = *(const GAS f32x2*)(cw + j * 1536 + col + 2 * wd);
                const f32x2 bj = *(const GAS f32x2*)(cb + col + 2 * wd);
#pragma unroll
                for (int rr = 0; rr < 4; ++rr) { float sl = bj.x, sh = bj.y;
#pragma unroll
                    for (int j = 0; j < 4; ++j) { sl += wj[j].x * xl[rr + j]; sh += wj[j].y * xh[rr + j]; }
                    outw[rr][wd] = pk2(siluf(sl), siluf(sh)); }
            }
#pragma unroll
            for (int rr = 0; rr < 4; ++rr) *(GAS v4u*)(PROJ + (size_t)(t0 + 4 * strip + rr) * PJ + col) = outw[rr];
        }
    }
    __syncthreads();
    {
        LAS bf16* mxs = (LAS bf16*)lds;
        LAS bf16* mcs = (LAS bf16*)(lds + 69680);
        LAS float* gp = (LAS float*)lds;
        const float* mcw = a.in[I_MCW] + (size_t)l * 4 * 512; const float* mcb = a.in[I_MCB] + (size_t)l * 512;
        const float* wif = a.in[I_WIF] + (size_t)l * 1536 * 8; const float* bif = a.in[I_BIF] + (size_t)l * 8;
        const bool sst = (t0 % T) == 0;
        for (int idx = tid; idx < 67 * 64; idx += NTHR) { const int rr = idx >> 6, ch = idx & 63;
            v4u v = (v4u){0u, 0u, 0u, 0u};
            if (!(sst && rr < 3)) v = *(const GAS v4u*)(PROJ + (size_t)(t0 - 3 + rr) * PJ + C_MX + ch * 8);
            *(LAS v4u*)(mxs + rr * MP + ch * 8) = v; }
        __syncthreads();
        { const int c = tid; const float w0 = mcw[c], w1 = mcw[512 + c], w2 = mcw[1024 + c], w3 = mcw[1536 + c], b0 = mcb[c];
          float x0 = bf2f(mxs[c]), x1 = bf2f(mxs[MP + c]), x2 = bf2f(mxs[2 * MP + c]);
#pragma unroll 8
          for (int tt = 0; tt < 64; ++tt) { const float x3 = bf2f(mxs[(tt + 3) * MP + c]); const float sacc = b0 + w0 * x0 + w1 * x1 + w2 * x2 + w3 * x3;
              mcs[tt * MP + c] = (bf16)f2bf(siluf(sacc)); x0 = x1; x1 = x2; x2 = x3; } }
        __syncthreads();
        float g[4][8];
#pragma unroll
        for (int tt = 0; tt < 4; ++tt)
#pragma unroll
            for (int j = 0; j < 8; ++j) g[tt][j] = 0.f;
#pragma unroll 1
        for (int combo = 0; combo < 12; ++combo) {
            const int which = combo >> 2, h = combo & 3, e0 = 16 * w;
            const bf16* wbase = WQKV + ((size_t)(which * 4 + h) * 128 + e0 + r) * 128 + 8 * q;
            s16x8 af[4];
#pragma unroll
            for (int ks = 0; ks < 4; ++ks) af[ks] = *(const GAS s16x8*)(wbase + 32 * ks);
            f32x4 wi[4][2];
#pragma unroll
            for (int i = 0; i < 4; ++i) { const float* p = wif + (size_t)(h * 384 + which * 128 + e0 + 4 * q + i) * 8; wi[i][0] = *(const GAS f32x4*)p; wi[i][1] = *(const GAS f32x4*)(p + 4); }
            const LAS bf16* src = (which == 2) ? (mxs + 3 * MP) : mcs;
#pragma unroll
            for (int tt = 0; tt < 4; ++tt) { f32x4 d = (f32x4){0.f, 0.f, 0.f, 0.f};
#pragma unroll
                for (int ks = 0; ks < 4; ++ks) d = MFMA16(af[ks], *(const LAS s16x8*)(src + (16 * tt + r) * MP + h * 128 + 32 * ks + 8 * q), d);
                { v2u o; o.x = pk2(d[0], d[1]); o.y = pk2(d[2], d[3]);
                  bf16* dstp = (which < 2) ? (XNQK + (size_t)(t0 + 16 * tt + r) * 1024 + which * 512) : (SCRV + (size_t)(t0 + 16 * tt + r) * 1024 + 512);
                  *(GAS v2u*)(dstp + h * 128 + e0 + 4 * q) = o; }
#pragma unroll
                for (int i = 0; i < 4; ++i) { g[tt][0] += d[i] * wi[i][0].x; g[tt][1] += d[i] * wi[i][0].y; g[tt][2] += d[i] * wi[i][0].z; g[tt][3] += d[i] * wi[i][0].w;
                    g[tt][4] += d[i] * wi[i][1].x; g[tt][5] += d[i] * wi[i][1].y; g[tt][6] += d[i] * wi[i][1].z; g[tt][7] += d[i] * wi[i][1].w; } }
        }
#pragma unroll
        for (int tt = 0; tt < 4; ++tt)
#pragma unroll
            for (int j = 0; j < 8; ++j) { g[tt][j] += __shfl_xor(g[tt][j], 16); g[tt][j] += __shfl_xor(g[tt][j], 32); }
        __syncthreads();
        if (q == 0) {
#pragma unroll
            for (int tt = 0; tt < 4; ++tt) { *(LAS f32x4*)(gp + (w * 64 + 16 * tt + r) * 8) = (f32x4){g[tt][0], g[tt][1], g[tt][2], g[tt][3]}; *(LAS f32x4*)(gp + (w * 64 + 16 * tt + r) * 8 + 4) = (f32x4){g[tt][4], g[tt][5], g[tt][6], g[tt][7]}; } }
        __syncthreads();
        { const int t = tid >> 3, j = tid & 7; float sacc = bif[j];
#pragma unroll
          for (int ww = 0; ww < 8; ++ww) sacc += gp[(ww * 64 + t) * 8 + j];
          const float gv_ = (j < 4) ? sacc : logsigmoidf(sacc);
          IFB[(size_t)(t0 + t) * 8 + j] = gv_; gp[4096 + t * 8 + j] = gv_; }
        __syncthreads();
        if (w < 4) {
            float* mlc = (float*)(ws + WS_MLC); float* mlp = (float*)(ws + WS_MLP);
            const float li_ = gp[4096 + lane * 8 + w]; float inc = gp[4096 + lane * 8 + 4 + w];
#pragma unroll
            for (int o = 1; o < 64; o <<= 1) { const float t = __shfl_up(inc, o); if (lane >= o) inc += t; }
            float pm = li_ - inc;
#pragma unroll
            for (int o = 1; o < 64; o <<= 1) { const float t = __shfl_up(pm, o); if (lane >= o) pm = fmaxf(pm, t); }
            mlc[(size_t)(t0 + lane) * 4 + w] = inc; mlp[(size_t)(t0 + lane) * 4 + w] = pm;
        }
        __syncthreads();
    }
    {
        LAS bf16* FT = (LAS bf16*)lds;
        LAS bf16* QT = (LAS bf16*)(lds + 17408);
        LAS float* psum = (LAS float*)(lds + 34816);
        float* HGV = (float*)(ws + WS_HGV);
        constexpr int HP = 136;
        const int k = tid & 127, tq = tid >> 7;
#pragma unroll 1
        for (int h = 0; h < 4; ++h) {
#pragma unroll
            for (int i = 0; i < 2; ++i) { const int idx = tid + NTHR * i, row = idx >> 4, ch = idx & 15;
                *(LAS v4u*)(FT + row * HP + ch * 8) = *(const GAS v4u*)(PROJ + (size_t)(t0 + row) * PJ + C_GF + h * 128 + ch * 8);
                *(LAS v4u*)(QT + row * HP + ch * 8) = *(const GAS v4u*)(PROJ + (size_t)(t0 + row) * PJ + C_GQ + h * 128 + ch * 8); }
            __syncthreads();
            const float lb = hg_lower_bound(a.in[I_HLB], l, h * 128 + k), omlb = 1.f - lb;
            float cum[16], kk[16], qq[16]; float run = 0.f;
#pragma unroll
            for (int j = 0; j < 16; ++j) { const int t = 16 * tq + j; const float sg = sigm(bf2f(FT[t * HP + k])); const float f = lb + omlb * sg; run += __logf(f); cum[j] = run; kk[j] = omlb * (1.f - sg); qq[j] = siluf(bf2f(QT[t * HP + k])); }
            psum[tq * 128 + k] = run;
            __syncthreads();
            { const float p0 = psum[k], p1 = psum[128 + k], p2 = psum[256 + k], p3 = psum[384 + k];
              const float cmid = p0 + p1, cend = cmid + p2 + p3;
              const float off = (tq == 0) ? 0.f : (tq == 1 ? p0 : (tq == 2 ? cmid : cmid + p2));
              if (tq == 0) { float* hv = HGV + ((size_t)tile * 4 + h) * 384; hv[k] = __expf(cmid); hv[128 + k] = __expf(cend - cmid); hv[256 + k] = __expf(cend); }
#pragma unroll
              for (int j = 0; j < 16; ++j) { const float cj = off + cum[j]; const float em = __expf(fminf(fmaxf(cj - cmid, -80.f), 80.f)), rem = __builtin_amdgcn_rcpf(em); const int t = 16 * tq + j;
                  QT[t * HP + k] = (bf16)f2bf(qq[j] * em); FT[t * HP + k] = (bf16)f2bf(kk[j] * rem); } }
            __syncthreads();
#pragma unroll
            for (int i = 0; i < 2; ++i) { const int idx = tid + NTHR * i, row = idx >> 4, ch = idx & 15;
                *(GAS v4u*)(PROJ + (size_t)(t0 + row) * PJ + C_GF + h * 128 + ch * 8) = *(const LAS v4u*)(FT + row * HP + ch * 8);
                *(GAS v4u*)(PROJ + (size_t)(t0 + row) * PJ + C_GQ + h * 128 + ch * 8) = *(const LAS v4u*)(QT + row * HP + ch * 8); }
            __syncthreads();
        }
    }
}


__device__ __forceinline__ void scan_ssd_naive(const Args& a, unsigned char* ws, int l, LAS unsigned char* lds, int b, int h, int tid) {
    bf16* PROJ = (bf16*)(ws + WS_PROJ); const float* DT = (const float*)(ws + WS_DT);
    LAS float* xs = (LAS float*)lds;
    LAS float* Bs = xs + 64 * 64;
    LAS float* Cs = Bs + 64 * 128;
    LAS float* ys = Cs + 64 * 128;
    LAS float* dts = ys + 64 * 64;
    const int p = tid >> 3, nq = tid & 7, n0 = nq * 16, g = h >> 3;
    const float aneg = -__expf(a.in[I_ALOG][l * 16 + h]), Dh = a.in[I_SD][l * 16 + h];
    float hs[16];
#pragma unroll
    for (int j = 0; j < 16; ++j) hs[j] = 0.f;
    for (int blk = 0; blk < T / 64; ++blk) {
        const size_t t0 = (size_t)b * T + blk * 64;
        for (int idx = tid; idx < 64 * 40; idx += NTHR) { const int r = idx / 40, ch = idx % 40;
            int col; LAS float* dst;
            if (ch < 8) { col = C_SX + h * 64 + ch * 8; dst = xs + r * 64 + ch * 8; }
            else if (ch < 24) { col = C_SB + g * 128 + (ch - 8) * 8; dst = Bs + r * 128 + (ch - 8) * 8; }
            else { col = C_SC + g * 128 + (ch - 24) * 8; dst = Cs + r * 128 + (ch - 24) * 8; }
            float f[8]; unpack8(*(const GAS v4u*)(PROJ + (t0 + r) * PJ + col), f);
#pragma unroll
            for (int e = 0; e < 8; ++e) dst[e] = f[e]; }
        if (tid < 64) dts[tid] = DT[(t0 + tid) * 16 + h];
        __syncthreads();
        for (int tt = 0; tt < 64; ++tt) {
            const float dt = dts[tt], dA = __expf(dt * aneg), xv = xs[tt * 64 + p], dx = dt * xv;
            float y = 0.f;
#pragma unroll
            for (int j = 0; j < 16; ++j) { hs[j] = dA * hs[j] + dx * Bs[tt * 128 + n0 + j]; y += Cs[tt * 128 + n0 + j] * hs[j]; }
            y += __shfl_xor(y, 1); y += __shfl_xor(y, 2); y += __shfl_xor(y, 4);
            if (nq == 0) ys[tt * 64 + p] = y + Dh * xv;
        }
        __syncthreads();
        { const int r = tid >> 3, c8 = (tid & 7) * 8; float o[8];
#pragma unroll
          for (int e = 0; e < 8; ++e) o[e] = ys[r * 64 + c8 + e];
          *(GAS v4u*)(PROJ + (t0 + r) * PJ + C_SX + h * 64 + c8) = pack8(o); }
        __syncthreads();
    }
}
__device__ __forceinline__ void scan_ml_naive(const Args& a, unsigned char* ws, int l, LAS unsigned char* lds, int b, int h, int tid) {
    const bf16* PROJ = (const bf16*)(ws + WS_PROJ); const bf16* QK = (const bf16*)(ws + WS_XN); bf16* SCR = (bf16*)(ws + WS_SCR);
    const float* IFB = (const float*)(ws + WS_IF); const bf16* WQKV = (const bf16*)(ws + WS_WQKV);
    LAS float* qs = (LAS float*)lds;
    LAS float* ks = qs + 64 * 128;
    LAS float* ms = ks + 64 * 128;
    LAS float* hs = ms + 64 * 128;
    LAS float* is = hs + 64 * 128;
    LAS float* fs = is + 64;
    const int dv = tid >> 2, eq = tid & 3, e0 = eq * 32;
    float wv[32];
    { const GAS v4u* wr = (const GAS v4u*)(WQKV + ((size_t)(2 * 4 + h) * 128 + dv) * 128 + e0);
#pragma unroll
      for (int c = 0; c < 4; ++c) { float f[8]; unpack8(wr[c], f);
#pragma unroll
          for (int e = 0; e < 8; ++e) wv[c * 8 + e] = f[e]; } }
    float Cst[32], nst[32];
#pragma unroll
    for (int j = 0; j < 32; ++j) { Cst[j] = 0.f; nst[j] = 0.f; }
    const float qscale = 0.08838834764831845f;
    for (int blk = 0; blk < T / 64; ++blk) {
        const size_t t0 = (size_t)b * T + blk * 64;
        for (int idx = tid; idx < 64 * 48; idx += NTHR) { const int r = idx / 48, ch = idx % 48;
            const bf16* src; LAS float* dst;
            if (ch < 16) { src = QK + (t0 + r) * 1024 + h * 128 + ch * 8; dst = qs + r * 128 + ch * 8; }
            else if (ch < 32) { src = QK + (t0 + r) * 1024 + 512 + h * 128 + (ch - 16) * 8; dst = ks + r * 128 + (ch - 16) * 8; }
            else { src = PROJ + (t0 + r) * PJ + C_MX + h * 128 + (ch - 32) * 8; dst = ms + r * 128 + (ch - 32) * 8; }
            float f[8]; unpack8(*(const GAS v4u*)src, f);
#pragma unroll
            for (int e = 0; e < 8; ++e) dst[e] = f[e]; }
        if (tid < 64) { is[tid] = IFB[(t0 + tid) * 8 + h]; fs[tid] = IFB[(t0 + tid) * 8 + 4 + h]; }
        __syncthreads();
        for (int tt = 0; tt < 64; ++tt) {
            float v = 0.f;
#pragma unroll
            for (int j = 0; j < 32; ++j) v += ms[tt * 128 + e0 + j] * wv[j];
            v += __shfl_xor(v, 1); v += __shfl_xor(v, 2);
            const float f = __expf(fs[tt]), ig = __expf(is[tt]), iv = ig * v;
            float num = 0.f, den = 0.f;
#pragma unroll
            for (int j = 0; j < 32; ++j) { const float kk = ks[tt * 128 + e0 + j], qq = qs[tt * 128 + e0 + j] * qscale;
                Cst[j] = f * Cst[j] + iv * kk; nst[j] = f * nst[j] + ig * kk; num += Cst[j] * qq; den += nst[j] * qq; }
            num += __shfl_xor(num, 1); num += __shfl_xor(num, 2); den += __shfl_xor(den, 1); den += __shfl_xor(den, 2);
            if (eq == 0) hs[tt * 128 + dv] = num / fmaxf(fabsf(den), 1.0f);
        }
        __syncthreads();
        for (int idx = tid; idx < 64 * 16; idx += NTHR) { const int r = idx >> 4, c8 = (idx & 15) * 8; float o[8];
#pragma unroll
            for (int e = 0; e < 8; ++e) o[e] = hs[r * 128 + c8 + e];
            *(GAS v4u*)(SCR + (t0 + r) * 1024 + h * 128 + c8) = pack8(o); }
        __syncthreads();
    }
}
__device__ __forceinline__ void scan_hg_naive(const Args& a, unsigned char* ws, int l, LAS unsigned char* lds, int b, int h, int tid) {
    const bf16* PROJ = (const bf16*)(ws + WS_PROJ); bf16* SCR = (bf16*)(ws + WS_SCR);
    LAS float* fs = (LAS float*)lds;
    LAS float* ks = fs + 32 * 128;
    LAS float* qs = ks + 32 * 128;
    LAS float* vs = qs + 32 * 128;
    LAS float* os = vs + 32 * 128;
    const int dv = tid >> 2, kq = tid & 3, k0 = kq * 32;
    float S[32];
#pragma unroll
    for (int j = 0; j < 32; ++j) S[j] = 0.f;
    const float* hlb = a.in[I_HLB];
    for (int blk = 0; blk < T / 32; ++blk) {
        const size_t t0 = (size_t)b * T + blk * 32;
        for (int idx = tid; idx < 32 * 16; idx += NTHR) { const int r = idx >> 4, c8 = (idx & 15) * 8; const int c = h * 128 + c8;
            float gq[8], gf[8], gi[8];
            unpack8(*(const GAS v4u*)(PROJ + (t0 + r) * PJ + C_GQ + c), gq); unpack8(*(const GAS v4u*)(PROJ + (t0 + r) * PJ + C_GF + c), gf); unpack8(*(const GAS v4u*)(PROJ + (t0 + r) * PJ + C_GI + c), gi);
#pragma unroll
            for (int e = 0; e < 8; ++e) { const float lb = hg_lower_bound(hlb, l, c + e); const float sg = sigm(gf[e]);
                fs[r * 128 + c8 + e] = lb + (1.f - lb) * sg; ks[r * 128 + c8 + e] = (1.f - lb) * (1.f - sg); qs[r * 128 + c8 + e] = siluf(gq[e]); vs[r * 128 + c8 + e] = gi[e]; } }
        __syncthreads();
        for (int tt = 0; tt < 32; ++tt) {
            const float v = vs[tt * 128 + dv]; float o = 0.f;
#pragma unroll
            for (int j = 0; j < 32; ++j) { S[j] = fs[tt * 128 + k0 + j] * S[j] + ks[tt * 128 + k0 + j] * v; o += S[j] * qs[tt * 128 + k0 + j]; }
            o += __shfl_xor(o, 1); o += __shfl_xor(o, 2);
            if (kq == 0) os[tt * 128 + dv] = o;
        }
        __syncthreads();
        { const int r = tid >> 4, c8 = (tid & 15) * 8; float o[8];
#pragma unroll
          for (int e = 0; e < 8; ++e) o[e] = os[r * 128 + c8 + e];
          *(GAS v4u*)(SCR + (t0 + r) * 1024 + 512 + h * 128 + c8) = pack8(o); }
        __syncthreads();
    }
}

constexpr int LP = 136;
__device__ __forceinline__ s16x8 ldfrag(const LAS bf16* base, int row0, int k0, int lane) {
    return *(const LAS s16x8*)(base + (row0 + (lane & 15)) * LP + k0 + (lane >> 4) * 8);
}
__device__ __forceinline__ unsigned short bfelem(const v4u v, int j) { const unsigned wd = v[j >> 1]; return (unsigned short)((j & 1) ? (wd >> 16) : (wd & 0xffffu)); }

constexpr int LQ = 72;
__device__ __forceinline__ s16x8 ldfrag72(const LAS bf16* base, int row0, int k0, int lane);
typedef short s16x4v __attribute__((ext_vector_type(4)));
__device__ __forceinline__ s16x8 ldfrag_tr(const LAS bf16* Tt, int pitch, int k0, int col0, int lane) {
    const LAS bf16* a0 = Tt + (k0 + 8 * (lane >> 4) + ((lane & 15) >> 2)) * pitch + col0 + 4 * (lane & 3);
    const s16x4v lo = __builtin_amdgcn_ds_read_tr16_b64_v4i16((LAS s16x4v*)a0), hi = __builtin_amdgcn_ds_read_tr16_b64_v4i16((LAS s16x4v*)(a0 + 4 * pitch));
    return (s16x8){lo.x, lo.y, lo.z, lo.w, hi.x, hi.y, hi.z, hi.w};
}
constexpr int XP = 40;
__device__ __forceinline__ void scan_ssd(const Args& a, unsigned char* ws, int l, LAS unsigned char* lds, int b, int h, int ph, int tid_in) {
    int tid = tid_in; asm volatile("" : "+v"(tid));
    bf16* PROJ = (bf16*)(ws + WS_PROJ); const float* DT = (const float*)(ws + WS_DT);
#define SSD_BM(X) ((LAS bf16*)(lds + (X) * 17408))
#define SSD_CM(X) ((LAS bf16*)(lds + 34816 + (X) * 17408))
#define SSD_SS(X) ((LAS bf16*)(lds + 69632 + (X) * 9216))
#define SSD_X(X)  ((LAS bf16*)(lds + 88064 + (X) * 5120))
#define SSD_XS(X) ((LAS bf16*)(lds + 98304 + (X) * 5120))
    LAS bf16* ST = (LAS bf16*)(lds + 108544);
#define SSD_CUM(X) ((LAS float*)(lds + 117248 + (X) * 256))
    LAS float* dts = (LAS float*)(lds + 117760);
    LAS float* wtab = (LAS float*)(lds + 118016);
    const int lane = tid & 63, w = __builtin_amdgcn_readfirstlane(tid >> 6), q = lane >> 4, r = lane & 15, g = h >> 3;
    const bool prod = w < 4; const int j4 = w & 3, gt = tid & 255;
    const float Dh = a.in[I_SD][l * 16 + h];
    const int colx = C_SX + h * 64 + ph * 32, colB = C_SB + g * 128, colC = C_SC + g * 128;
    f32x4 st[2][2];
#pragma unroll
    for (int kt = 0; kt < 2; ++kt) { st[kt][0] = (f32x4){0.f, 0.f, 0.f, 0.f}; st[kt][1] = (f32x4){0.f, 0.f, 0.f, 0.f}; }
    for (int i = tid; i < 32 * LP / 2; i += NTHR) ((LAS unsigned*)ST)[i] = 0u;
    v4u rb[4], rc[4], rx; float fd = 0.f, fc = 0.f;
#pragma unroll
    for (int i = 0; i < 4; ++i) { rb[i] = (v4u){0u, 0u, 0u, 0u}; rc[i] = (v4u){0u, 0u, 0u, 0u}; }
    rx = (v4u){0u, 0u, 0u, 0u};
    const float* SC64 = (const float*)(ws + ((b < 2) ? WS_SC64A : WS_SC64B)) + (size_t)(b & 1) * T * 16;
    const int vrow = gt >> 2, vch = gt & 3;
#define SSD_LOAD(cc) do { const size_t t0_ = (size_t)b * T + (size_t)(cc) * 64; \
        _Pragma("unroll") for (int i = 0; i < 4; ++i) { const int idx = gt + 256 * i, row = idx >> 4, ch = idx & 15; \
            rb[i] = *(const GAS v4u*)(PROJ + (t0_ + row) * PJ + colB + ch * 8); rc[i] = *(const GAS v4u*)(PROJ + (t0_ + row) * PJ + colC + ch * 8); } \
        rx = *(const GAS v4u*)(PROJ + (t0_ + vrow) * PJ + colx + vch * 8); \
        fd = DT[(t0_ + lane) * 16 + h]; fc = SC64[((size_t)(cc) * 64 + lane) * 16 + h]; } while (0)
    unsigned ob[2][2] = {{0u, 0u}, {0u, 0u}};
#define SSD_STORE(cc) do { bf16* op_ = PROJ + ((size_t)b * T + (size_t)(cc) * 64 + 16 * j4 + r) * PJ + colx + 4 * q; \
        _Pragma("unroll") for (int pt = 0; pt < 2; ++pt) { v2u o_; o_.x = ob[pt][0]; o_.y = ob[pt][1]; *(GAS v2u*)(op_ + 16 * pt) = o_; } } while (0)
    if (prod) SSD_LOAD(0);
    LDS_BARRIER();
    s16x8 xf[2][2];
#pragma unroll
    for (int pt = 0; pt < 2; ++pt) { xf[pt][0] = (s16x8){0, 0, 0, 0, 0, 0, 0, 0}; xf[pt][1] = (s16x8){0, 0, 0, 0, 0, 0, 0, 0}; }
#pragma unroll 1
    for (int c = -1; c < T / 64; ++c) {
        const int n = c + 1, bb = n & 1, cb = c & 1;
        if (prod) {
            if (n < T / 64) {
#pragma unroll
                for (int i = 0; i < 4; ++i) { const int idx = gt + 256 * i, row = idx >> 4, ch = idx & 15;
                    *(LAS v4u*)(SSD_BM(bb) + row * LP + ch * 8) = rb[i]; *(LAS v4u*)(SSD_CM(bb) + row * LP + ch * 8) = rc[i]; }
                *(LAS v4u*)(SSD_X(bb) + vrow * XP + vch * 8) = rx;
                const float ce = __int_as_float(__builtin_amdgcn_readlane(__float_as_int(fc), 63));
                {
                    const float sv = __shfl(fd * __expf(ce - fc), 16 * j4 + (lane >> 2)); float xs_[8]; unpack8(rx, xs_);
#pragma unroll
                    for (int jj = 0; jj < 8; ++jj) xs_[jj] *= sv;
                    *(LAS v4u*)(SSD_XS(bb) + vrow * XP + vch * 8) = pack8(xs_); }
                if (w == 0) { SSD_CUM(bb)[lane] = fc; dts[lane] = fd; }
                else { const float cref = __int_as_float(__builtin_amdgcn_readlane(__float_as_int(fc), 16 * j4 - 1)); wtab[j4 * 64 + lane] = fd * __expf(fminf(cref - fc, 0.f)); }
                if (n + 1 < T / 64) SSD_LOAD(n + 1);
            }
        } else if (c >= 0) {
            s16x8 cf[4], sf[2][4], sa[2];
#pragma unroll
            for (int ks = 0; ks < 2; ++ks) { sa[ks] = ldfrag72(SSD_SS(cb), 16 * j4, 32 * ks, lane); xf[0][ks] = ldfrag_tr(SSD_X(cb), XP, 32 * ks, 0, lane); xf[1][ks] = ldfrag_tr(SSD_X(cb), XP, 32 * ks, 16, lane); }
#pragma unroll
            for (int ks = 0; ks < 4; ++ks) { cf[ks] = ldfrag(SSD_CM(cb), 16 * j4, 32 * ks, lane); sf[0][ks] = ldfrag(ST, 0, 32 * ks, lane); sf[1][ks] = ldfrag(ST, 16, 32 * ks, lane); }
            const float cl1 = SSD_CUM(cb)[16 * j4 + r];
            v2u xr[2];
#pragma unroll
            for (int pt = 0; pt < 2; ++pt) xr[pt] = *(const LAS v2u*)(SSD_X(cb) + (16 * j4 + r) * XP + 16 * pt + 4 * q);
            SCHED_FENCE();
            f32x4 d3[2], d2[2];
#pragma unroll
            for (int pt = 0; pt < 2; ++pt) { d3[pt] = (f32x4){0.f, 0.f, 0.f, 0.f}; d2[pt] = (f32x4){0.f, 0.f, 0.f, 0.f}; }
#pragma unroll
            for (int ks = 0; ks < 2; ++ks) { d2[0] = MFMA16(xf[0][ks], sa[ks], d2[0]); d2[1] = MFMA16(xf[1][ks], sa[ks], d2[1]); }
#pragma unroll
            for (int ks = 0; ks < 4; ++ks) { d3[0] = MFMA16(sf[0][ks], cf[ks], d3[0]); d3[1] = MFMA16(sf[1][ks], cf[ks], d3[1]); }
            SCHED_FENCE();
            if (c > 0) SSD_STORE(c - 1);
            const float el = __expf(cl1);
#pragma unroll
            for (int pt = 0; pt < 2; ++pt) { float y4[4]; const float x4[4] = {blo(xr[pt].x), bhi(xr[pt].x), blo(xr[pt].y), bhi(xr[pt].y)};
#pragma unroll
                for (int i = 0; i < 4; ++i) y4[i] = d2[pt][i] + el * d3[pt][i] + Dh * x4[i];
                ob[pt][0] = pk2(y4[0], y4[1]); ob[pt][1] = pk2(y4[2], y4[3]); }
        }
        LDS_BARRIER();
        if (prod) {
            if (n < T / 64) {
                int lrow = 16 * j4 + r; asm volatile("" : "+v"(lrow));
                const LAS float* cum = SSD_CUM(bb);
                const LAS float* wt = wtab + j4 * 64;
                s16x8 cf[4], fa[2][4];
#pragma unroll
                for (int ks = 0; ks < 4; ++ks) cf[ks] = ldfrag(SSD_CM(bb), 16 * j4, 32 * ks, lane);
#pragma unroll
                for (int si = 0; si < 2; ++si)
#pragma unroll
                    for (int ks = 0; ks < 4; ++ks) fa[si][ks] = ldfrag(SSD_BM(bb), 16 * si, 32 * ks, lane);
                const float cl = cum[lrow], cref = cum[(j4 > 0) ? 16 * j4 - 1 : 0];
                const f32x4 cs = *(const LAS f32x4*)(cum + 16 * j4 + 4 * q), ds = *(const LAS f32x4*)(dts + 16 * j4 + 4 * q);
                f32x4 wt4[3];
#pragma unroll
                for (int si = 0; si < 3; ++si) wt4[si] = *(const LAS f32x4*)(wt + 16 * si + 4 * q);
                SCHED_FENCE();
                f32x4 d[4];
#pragma unroll
                for (int si = 0; si < 4; ++si) d[si] = (f32x4){0.f, 0.f, 0.f, 0.f};
#pragma unroll
                for (int ks = 0; ks < 4; ++ks)
#pragma unroll
                    for (int si = 0; si < 2; ++si) d[si] = MFMA16(fa[si][ks], cf[ks], d[si]);
                if (j4 >= 2) {
                    s16x8 fb[2][4];
#pragma unroll
                    for (int si = 0; si < 2; ++si)
#pragma unroll
                        for (int ks = 0; ks < 4; ++ks) fb[si][ks] = ldfrag(SSD_BM(bb), 16 * (2 + si), 32 * ks, lane);
                    SCHED_FENCE();
#pragma unroll
                    for (int ks = 0; ks < 4; ++ks)
#pragma unroll
                        for (int si = 0; si < 2; ++si) d[2 + si] = MFMA16(fb[si][ks], cf[ks], d[2 + si]);
                }
                const float rowfac = __expf(fminf(cl - cref, 0.f));
                float dg[4];
#pragma unroll
                for (int i = 0; i < 4; ++i) dg[i] = (16 * j4 + 4 * q + i <= lrow) ? __expf(fminf(cl - cs[i], 0.f)) * ds[i] : 0.f;
                SCHED_FENCE();
#pragma unroll
                for (int si = 0; si < 4; ++si) { const int s0 = 16 * si + 4 * q; float v[4];
#pragma unroll
                    for (int i = 0; i < 4; ++i) { const float fac = (si < j4) ? rowfac * wt4[si < 3 ? si : 2][i] : ((si == j4) ? dg[i] : 0.f); v[i] = (si <= j4) ? d[si][i] * fac : 0.f; }
                    v2u o; o.x = pk2(v[0], v[1]); o.y = pk2(v[2], v[3]); *(LAS v2u*)(SSD_SS(bb) + lrow * LQ + s0) = o; }
            }
        } else if (c >= 0) {
            s16x8 ba[2][2], xsf[2][2];
#pragma unroll
            for (int kt = 0; kt < 2; ++kt)
#pragma unroll
                for (int ks = 0; ks < 2; ++ks) ba[kt][ks] = ldfrag_tr(SSD_BM(cb), LP, 32 * ks, 16 * (2 * j4 + kt), lane);
#pragma unroll
            for (int pt = 0; pt < 2; ++pt)
#pragma unroll
                for (int ks = 0; ks < 2; ++ks) xsf[pt][ks] = ldfrag_tr(SSD_XS(cb), XP, 32 * ks, 16 * pt, lane);
            const float dec = __expf(SSD_CUM(cb)[63]);
#pragma unroll
            for (int kt = 0; kt < 2; ++kt) { st[kt][0] = st[kt][0] * dec; st[kt][1] = st[kt][1] * dec; }
            SCHED_FENCE();
#pragma unroll
            for (int ks = 0; ks < 2; ++ks)
#pragma unroll
                for (int kt = 0; kt < 2; ++kt) { st[kt][0] = MFMA16(ba[kt][ks], xsf[0][ks], st[kt][0]); st[kt][1] = MFMA16(ba[kt][ks], xsf[1][ks], st[kt][1]); }
            SCHED_FENCE();
#pragma unroll
            for (int kt = 0; kt < 2; ++kt)
#pragma unroll
                for (int pt = 0; pt < 2; ++pt) { v2u o; o.x = pk2(st[kt][pt][0], st[kt][pt][1]); o.y = pk2(st[kt][pt][2], st[kt][pt][3]);
                    *(LAS v2u*)(ST + (16 * pt + r) * LP + 16 * (2 * j4 + kt) + 4 * q) = o; }
        }
        LDS_BARRIER();
    }
    if (!prod) SSD_STORE(T / 64 - 1);
#undef SSD_STORE
#undef SSD_LOAD
#undef SSD_CM
#undef SSD_BM
#undef SSD_XS
#undef SSD_SS
#undef SSD_X
#undef SSD_CUM
}
__device__ __forceinline__ s16x8 ldfrag72(const LAS bf16* base, int row0, int k0, int lane);
__device__ __forceinline__ void scan_ml(const Args& a, unsigned char* ws, int l, LAS unsigned char* lds, int b, int h, int dq, int tid_in) {
    int tid = tid_in; asm volatile("" : "+v"(tid));
    const bf16* QK = (const bf16*)(ws + WS_XN); bf16* SCR = (bf16*)(ws + WS_SCR); const float* IFB = (const float*)(ws + WS_IF);
    const float* MLC = (const float*)(ws + WS_MLC); const float* MLP = (const float*)(ws + WS_MLP);
    constexpr int LQ_ = 72, VSP = 56;
#define ML_Q(X)  ((LAS bf16*)(lds + (X) * 17408))
#define ML_K(X)  ((LAS bf16*)(lds + 34816 + (X) * 17408))
#define ML_P(X)  ((LAS bf16*)(lds + 69632 + (X) * 9216))
#define ML_V(X)  ((LAS bf16*)(lds + 88064 + (X) * 5120))
#define ML_VS(X) ((LAS bf16*)(lds + 98304 + (X) * 7168))
    LAS bf16* CS = (LAS bf16*)(lds + 112640);
    LAS bf16* NS = (LAS bf16*)(lds + 121344);
#define ML_VEC(X) ((LAS float*)(lds + 125696 + (X) * 1024))
    LAS float* rowfv = (LAS float*)(lds + 127744);
    LAS float* colfv = rowfv + 64;
    LAS float* denv = (LAS float*)(lds + 128256);
    const int lane = tid & 63, w = __builtin_amdgcn_readfirstlane(tid >> 6), q = lane >> 4, r = lane & 15;
    const bool prod = w < 4; const int j4 = w & 3, gt = tid & 255;
    const float qscale = 0.08838834764831845f;
    f32x4 cst[2][2], nreg[2];
#pragma unroll
    for (int et = 0; et < 2; ++et) { cst[et][0] = (f32x4){0.f, 0.f, 0.f, 0.f}; cst[et][1] = (f32x4){0.f, 0.f, 0.f, 0.f}; nreg[et] = (f32x4){0.f, 0.f, 0.f, 0.f}; }
    float m_s = 0.f;
    for (int i = tid; i < (32 + 16) * LP / 2; i += NTHR) ((LAS unsigned*)CS)[i] = 0u;
    for (int i = tid; i < 2 * 64 * VSP / 2; i += NTHR) ((LAS unsigned*)ML_VS(0))[i] = 0u;
    v4u rq[4], rk[4], rv, rvk; float pli = 0.f, pc = 0.f, pp = 0.f;
#pragma unroll
    for (int i = 0; i < 4; ++i) { rq[i] = (v4u){0u, 0u, 0u, 0u}; rk[i] = (v4u){0u, 0u, 0u, 0u}; }
    rv = (v4u){0u, 0u, 0u, 0u}; rvk = rv;
    const int vrow = gt >> 2, vch = gt & 3;
#define ML_LOAD(cc) do { const size_t t0_ = (size_t)b * T + (size_t)(cc) * 64; \
        _Pragma("unroll") for (int i = 0; i < 4; ++i) { const int idx = gt + 256 * i, row = idx >> 4, ch = idx & 15; \
            rq[i] = *(const GAS v4u*)(QK + (t0_ + row) * 1024 + h * 128 + ch * 8); rk[i] = *(const GAS v4u*)(QK + (t0_ + row) * 1024 + 512 + h * 128 + ch * 8); } \
        rv = *(const GAS v4u*)(SCR + (t0_ + vrow) * 1024 + 512 + h * 128 + dq * 32 + vch * 8); \
        if (w == 0) { pli = IFB[(t0_ + lane) * 8 + h]; pc = MLC[(t0_ + lane) * 4 + h]; pp = MLP[(t0_ + lane) * 4 + h]; } } while (0)
    unsigned ob[4] = {0u, 0u, 0u, 0u};
#define ML_STORE(cc) do { bf16* op_ = SCR + ((size_t)b * T + (size_t)(cc) * 64 + 16 * j4 + r) * 1024 + h * 128 + dq * 32 + 4 * q; \
        _Pragma("unroll") for (int dvt = 0; dvt < 2; ++dvt) { v2u o_; o_.x = ob[2 * dvt]; o_.y = ob[2 * dvt + 1]; *(GAS v2u*)(op_ + 16 * dvt) = o_; } } while (0)
    if (prod) ML_LOAD(0);
    LDS_BARRIER();
    f32x4 d2[2], d3[2];
    d2[0] = d2[1] = d3[0] = d3[1] = (f32x4){0.f, 0.f, 0.f, 0.f};
#pragma unroll 1
    for (int c = -1; c < T / 64; ++c) {
        const int n = c + 1, bb = n & 1, cb = c & 1;
        if (prod) {
            if (n < T / 64) {
#pragma unroll
                for (int i = 0; i < 4; ++i) { const int idx = gt + 256 * i, row = idx >> 4, ch = idx & 15;
                    *(LAS v4u*)(ML_Q(bb) + row * LP + ch * 8) = rq[i]; *(LAS v4u*)(ML_K(bb) + row * LP + ch * 8) = rk[i]; }
                *(LAS v4u*)(ML_V(bb) + vrow * XP + vch * 8) = rv; rvk = rv;
                if (w == 0) {
                    const float g = __int_as_float(__builtin_amdgcn_readlane(__float_as_int(pp), 63)), cend = __int_as_float(__builtin_amdgcn_readlane(__float_as_int(pc), 63));
                    const float mloc = cend + g;
                    const float mt_ = fmaxf(pc + m_s, pc + pp);
                    const float m_new = fmaxf(cend + m_s, mloc);
                    LAS float* vb_ = ML_VEC(bb);
                    vb_[lane] = __expf(pc + m_s - mt_); vb_[64 + lane] = __expf(-mt_);
                    rowfv[lane] = qscale * __expf(fminf(pc + g - mt_, 80.f)); colfv[lane] = __expf(pli - pc - g);
                    if (lane == 0) { vb_[192] = __expf(cend + m_s - m_new); vb_[193] = __expf(mloc - m_new); }
                    m_s = m_new;
                }
                if (n + 1 < T / 64) ML_LOAD(n + 1);
            }
        } else if (c >= 0) {
            const LAS float* vc_ = ML_VEC(cb);
            s16x8 qf[4], cfr[2][4], nsf[4], pf[2], v0[2], v1[2];
#pragma unroll
            for (int ks = 0; ks < 2; ++ks) { pf[ks] = ldfrag72(ML_P(cb), 16 * j4, 32 * ks, lane); v0[ks] = ldfrag_tr(ML_V(cb), XP, 32 * ks, 0, lane); v1[ks] = ldfrag_tr(ML_V(cb), XP, 32 * ks, 16, lane); }
#pragma unroll
            for (int ks = 0; ks < 4; ++ks) { qf[ks] = ldfrag(ML_Q(cb), 16 * j4, 32 * ks, lane); cfr[0][ks] = ldfrag(CS, 0, 32 * ks, lane); cfr[1][ks] = ldfrag(CS, 16, 32 * ks, lane); nsf[ks] = ldfrag(NS, 0, 32 * ks, lane); }
            const float rs1 = vc_[128 + 16 * j4 + r], wi1 = vc_[16 * j4 + r], em1 = vc_[64 + 16 * j4 + r];
            SCHED_FENCE();
            f32x4 dn = (f32x4){0.f, 0.f, 0.f, 0.f};
            d2[0] = (f32x4){0.f, 0.f, 0.f, 0.f}; d2[1] = (f32x4){0.f, 0.f, 0.f, 0.f}; d3[0] = (f32x4){0.f, 0.f, 0.f, 0.f}; d3[1] = (f32x4){0.f, 0.f, 0.f, 0.f};
#pragma unroll
            for (int ks = 0; ks < 2; ++ks) { d2[0] = MFMA16(v0[ks], pf[ks], d2[0]); d2[1] = MFMA16(v1[ks], pf[ks], d2[1]); }
#pragma unroll
            for (int ks = 0; ks < 4; ++ks) { d3[0] = MFMA16(cfr[0][ks], qf[ks], d3[0]); d3[1] = MFMA16(cfr[1][ks], qf[ks], d3[1]); dn = MFMA16(nsf[ks], qf[ks], dn); }
            SCHED_FENCE();
            if (q == 0) denv[16 * j4 + r] = fmaxf(fabsf(rs1 + wi1 * qscale * dn[0]), em1);
        }
        LDS_BARRIER();
        if (prod) {
            if (n < T / 64) {
                int lrow = 16 * j4 + r; asm volatile("" : "+v"(lrow));
                s16x8 qf[4], fa[2][4]; f32x4 cf4[4];
#pragma unroll
                for (int ks = 0; ks < 4; ++ks) qf[ks] = ldfrag(ML_Q(bb), 16 * j4, 32 * ks, lane);
#pragma unroll
                for (int si = 0; si < 2; ++si)
#pragma unroll
                    for (int ks = 0; ks < 4; ++ks) fa[si][ks] = ldfrag(ML_K(bb), 16 * si, 32 * ks, lane);
                const float a_loc = ML_VEC(bb)[193], rf = rowfv[lrow];
                const float wv = colfv[vrow] * a_loc;
#pragma unroll
                for (int si = 0; si < 4; ++si) cf4[si] = *(const LAS f32x4*)(colfv + 16 * si + 4 * q);
                SCHED_FENCE();
                { float f8[8]; unpack8(rvk, f8);
#pragma unroll
                  for (int jj = 0; jj < 8; ++jj) f8[jj] *= wv;
                  *(LAS v4u*)(ML_VS(bb) + vrow * VSP + vch * 8) = pack8(f8);
                  if (vch == 0) { v4u o = (v4u){f2bf(wv), 0u, 0u, 0u}; *(LAS v4u*)(ML_VS(bb) + vrow * VSP + 32) = o; } }
                f32x4 d1[4];
#pragma unroll
                for (int si = 0; si < 4; ++si) d1[si] = (f32x4){0.f, 0.f, 0.f, 0.f};
#pragma unroll
                for (int ks = 0; ks < 4; ++ks)
#pragma unroll
                    for (int si = 0; si < 2; ++si) d1[si] = MFMA16(fa[si][ks], qf[ks], d1[si]);
                if (j4 >= 2) {
                    s16x8 fb[2][4];
#pragma unroll
                    for (int si = 0; si < 2; ++si)
#pragma unroll
                        for (int ks = 0; ks < 4; ++ks) fb[si][ks] = ldfrag(ML_K(bb), 16 * (2 + si), 32 * ks, lane);
                    SCHED_FENCE();
#pragma unroll
                    for (int ks = 0; ks < 4; ++ks)
#pragma unroll
                        for (int si = 0; si < 2; ++si) d1[2 + si] = MFMA16(fb[si][ks], qf[ks], d1[2 + si]);
                }
                SCHED_FENCE();
                float rowsum = 0.f;
#pragma unroll
                for (int si = 0; si < 4; ++si) { const int s0 = 16 * si + 4 * q; float v[4];
#pragma unroll
                    for (int i = 0; i < 4; ++i) { v[i] = (s0 + i <= lrow) ? d1[si][i] * (rf * cf4[si][i]) : 0.f; rowsum += v[i]; }
                    v2u o; o.x = pk2(v[0], v[1]); o.y = pk2(v[2], v[3]); *(LAS v2u*)(ML_P(bb) + lrow * LQ_ + s0) = o; }
                rowsum += __shfl_xor(rowsum, 16); rowsum += __shfl_xor(rowsum, 32);
                if (q == 0) ML_VEC(bb)[128 + lrow] = rowsum;
            }
        } else if (c >= 0) {
            const LAS float* vc_ = ML_VEC(cb);
            s16x8 kf[2][2], vs[3][2];
#pragma unroll
            for (int et = 0; et < 2; ++et)
#pragma unroll
                for (int ks = 0; ks < 2; ++ks) kf[et][ks] = ldfrag_tr(ML_K(cb), LP, 32 * ks, 16 * (2 * j4 + et), lane);
#pragma unroll
            for (int t3 = 0; t3 < 3; ++t3)
#pragma unroll
                for (int ks = 0; ks < 2; ++ks) vs[t3][ks] = ldfrag_tr(ML_VS(cb), VSP, 32 * ks, 16 * t3, lane);
            const float wi1 = vc_[16 * j4 + r] * qscale, dn1 = denv[16 * j4 + r];
            const float a_old = vc_[192];
            SCHED_FENCE();
            if (c > 0) ML_STORE(c - 1);
#pragma unroll
            for (int et = 0; et < 2; ++et) { cst[et][0] = cst[et][0] * a_old; cst[et][1] = cst[et][1] * a_old; nreg[et] = nreg[et] * a_old; }
#pragma unroll
            for (int ks = 0; ks < 2; ++ks)
#pragma unroll
                for (int et = 0; et < 2; ++et) { cst[et][0] = MFMA16(kf[et][ks], vs[0][ks], cst[et][0]); cst[et][1] = MFMA16(kf[et][ks], vs[1][ks], cst[et][1]); nreg[et] = MFMA16(kf[et][ks], vs[2][ks], nreg[et]); }
            const float inv1 = __builtin_amdgcn_rcpf(dn1);
#pragma unroll
            for (int dvt = 0; dvt < 2; ++dvt) { float o4[4];
#pragma unroll
                for (int i = 0; i < 4; ++i) o4[i] = (d2[dvt][i] + wi1 * d3[dvt][i]) * inv1;
                ob[2 * dvt] = pk2(o4[0], o4[1]); ob[2 * dvt + 1] = pk2(o4[2], o4[3]); }
            SCHED_FENCE();
#pragma unroll
            for (int et = 0; et < 2; ++et) {
#pragma unroll
                for (int dvt = 0; dvt < 2; ++dvt) { v2u o; o.x = pk2(cst[et][dvt][0], cst[et][dvt][1]); o.y = pk2(cst[et][dvt][2], cst[et][dvt][3]);
                    *(LAS v2u*)(CS + (16 * dvt + r) * LP + 16 * (2 * j4 + et) + 4 * q) = o; }
                if (r == 0) { v2u o; o.x = pk2(nreg[et][0], nreg[et][1]); o.y = pk2(nreg[et][2], nreg[et][3]); *(LAS v2u*)(NS + 16 * (2 * j4 + et) + 4 * q) = o; } }
        }
        LDS_BARRIER();
    }
    if (!prod) ML_STORE(T / 64 - 1);
}
#undef ML_LOAD
#undef ML_STORE
#undef ML_Q
#undef ML_K
#undef ML_P
#undef ML_V
#undef ML_VS
#undef ML_VEC
__device__ __forceinline__ s16x8 ldfrag72(const LAS bf16* base, int row0, int k0, int lane) {
    return *(const LAS s16x8*)(base + (row0 + (lane & 15)) * LQ + k0 + (lane >> 4) * 8);
}
__device__ __forceinline__ void scan_hg(const Args& a, unsigned char* ws, int l, LAS unsigned char* lds, int b, int h, int dq, int tid_in) {
    int tid = tid_in; asm volatile("" : "+v"(tid));
    const bf16* PROJ = (const bf16*)(ws + WS_PROJ); bf16* PROJW = (bf16*)(ws + WS_PROJ); const float* HGV = (const float*)(ws + WS_HGV);
#define HG_QM(X) ((LAS bf16*)(lds + (X) * 17408))
#define HG_KM(X) ((LAS bf16*)(lds + 34816 + (X) * 17408))
#define HG_P(X)  ((LAS bf16*)(lds + 69632 + (X) * 9216))
#define HG_V(X)  ((LAS bf16*)(lds + 88064 + (X) * 5120))
    LAS bf16* ST = (LAS bf16*)(lds + 98304);
#define HG_VEC(X) ((LAS float*)(lds + 107008 + (X) * 1536))
    const int lane = tid & 63, w = __builtin_amdgcn_readfirstlane(tid >> 6), q = lane >> 4, r = lane & 15;
    const bool prod = w < 4; const int j4 = w & 3, gt = tid & 255;
    f32x4 st[2][2];
#pragma unroll
    for (int kt = 0; kt < 2; ++kt) { st[kt][0] = (f32x4){0.f, 0.f, 0.f, 0.f}; st[kt][1] = (f32x4){0.f, 0.f, 0.f, 0.f}; }
    for (int i = tid; i < 32 * LP / 2; i += NTHR) ((LAS unsigned*)ST)[i] = 0u;
    v4u rq[4], rk[4], rv; float fv0 = 0.f, fv1 = 0.f;
#pragma unroll
    for (int i = 0; i < 4; ++i) { rq[i] = (v4u){0u, 0u, 0u, 0u}; rk[i] = (v4u){0u, 0u, 0u, 0u}; }
    rv = (v4u){0u, 0u, 0u, 0u};
    const int vrow = gt >> 2, vch = gt & 3;
#define HG_LOAD(cc) do { const size_t t0_ = (size_t)b * T + (size_t)(cc) * 64; \
        _Pragma("unroll") for (int i = 0; i < 4; ++i) { const int idx = gt + 256 * i, row = idx >> 4, ch = idx & 15; \
            rq[i] = *(const GAS v4u*)(PROJ + (t0_ + row) * PJ + C_GQ + h * 128 + ch * 8); rk[i] = *(const GAS v4u*)(PROJ + (t0_ + row) * PJ + C_GF + h * 128 + ch * 8); } \
        rv = *(const GAS v4u*)(PROJ + (t0_ + vrow) * PJ + C_GI + h * 128 + dq * 32 + vch * 8); \
        const size_t ch_ = (size_t)b * (T / 64) + (cc); \
        fv0 = HGV[(ch_ * 4 + h) * 384 + gt]; if (gt < 128) fv1 = HGV[(ch_ * 4 + h) * 384 + 256 + gt]; } while (0)
    unsigned ob[2][2] = {{0u, 0u}, {0u, 0u}};
#define HG_STORE(cc) do { bf16* op_ = PROJW + ((size_t)b * T + (size_t)(cc) * 64 + 16 * j4 + r) * PJ + C_GI + h * 128 + dq * 32 + 4 * q; \
        _Pragma("unroll") for (int dvt = 0; dvt < 2; ++dvt) { v2u o_; o_.x = ob[dvt][0]; o_.y = ob[dvt][1]; *(GAS v2u*)(op_ + 16 * dvt) = o_; } } while (0)
    if (prod) HG_LOAD(0);
    LDS_BARRIER();
#pragma unroll 1
    for (int c = -1; c < T / 64; ++c) {
        const int n = c + 1, bb = n & 1, cb = c & 1;
        if (prod) {
            if (n < T / 64) {
#pragma unroll
                for (int i = 0; i < 4; ++i) { const int idx = gt + 256 * i, row = idx >> 4, ch = idx & 15;
                    *(LAS v4u*)(HG_QM(bb) + row * LP + ch * 8) = rq[i]; *(LAS v4u*)(HG_KM(bb) + row * LP + ch * 8) = rk[i]; }
                *(LAS v4u*)(HG_V(bb) + vrow * XP + vch * 8) = rv;
                HG_VEC(bb)[gt] = fv0; if (gt < 128) HG_VEC(bb)[256 + gt] = fv1;
                if (n + 1 < T / 64) HG_LOAD(n + 1);
            }
        } else if (c >= 0) {
            const LAS float* vc_ = HG_VEC(cb);
            s16x8 pfr[2], qfr[4], vf0[2], vf1[2], s0f[4], s1f[4], kf[2][2]; f32x4 ev[2], ee[2];
#pragma unroll
            for (int ks = 0; ks < 2; ++ks) { pfr[ks] = ldfrag72(HG_P(cb), 16 * j4, 32 * ks, lane); vf0[ks] = ldfrag_tr(HG_V(cb), XP, 32 * ks, 0, lane); vf1[ks] = ldfrag_tr(HG_V(cb), XP, 32 * ks, 16, lane); }
#pragma unroll
            for (int kt = 0; kt < 2; ++kt)
#pragma unroll
                for (int ks = 0; ks < 2; ++ks) kf[kt][ks] = ldfrag_tr(HG_KM(cb), LP, 32 * ks, 16 * (2 * j4 + kt), lane);
#pragma unroll
            for (int ks = 0; ks < 4; ++ks) { qfr[ks] = ldfrag(HG_QM(cb), 16 * j4, 32 * ks, lane); s0f[ks] = ldfrag(ST, 0, 32 * ks, lane); s1f[ks] = ldfrag(ST, 16, 32 * ks, lane); }
#pragma unroll
            for (int kt = 0; kt < 2; ++kt) { ev[kt] = *(const LAS f32x4*)(vc_ + 256 + 16 * (2 * j4 + kt) + 4 * q); ee[kt] = *(const LAS f32x4*)(vc_ + 128 + 16 * (2 * j4 + kt) + 4 * q); }
            SCHED_FENCE();
            f32x4 d0 = (f32x4){0.f, 0.f, 0.f, 0.f}, d1 = (f32x4){0.f, 0.f, 0.f, 0.f}, u[2][2];
#pragma unroll
            for (int kt = 0; kt < 2; ++kt) { u[kt][0] = (f32x4){0.f, 0.f, 0.f, 0.f}; u[kt][1] = (f32x4){0.f, 0.f, 0.f, 0.f}; }
#pragma unroll
            for (int ks = 0; ks < 2; ++ks) { d0 = MFMA16(vf0[ks], pfr[ks], d0); d1 = MFMA16(vf1[ks], pfr[ks], d1);
#pragma unroll
                for (int kt = 0; kt < 2; ++kt) { u[kt][0] = MFMA16(kf[kt][ks], vf0[ks], u[kt][0]); u[kt][1] = MFMA16(kf[kt][ks], vf1[ks], u[kt][1]); } }
#pragma unroll
            for (int ks = 0; ks < 4; ++ks) { d0 = MFMA16(s0f[ks], qfr[ks], d0); d1 = MFMA16(s1f[ks], qfr[ks], d1); }
            SCHED_FENCE();
            if (c > 0) HG_STORE(c - 1);
            ob[0][0] = pk2(d0[0], d0[1]); ob[0][1] = pk2(d0[2], d0[3]); ob[1][0] = pk2(d1[0], d1[1]); ob[1][1] = pk2(d1[2], d1[3]);
#pragma unroll
            for (int kt = 0; kt < 2; ++kt) { st[kt][0] = st[kt][0] * ev[kt] + u[kt][0] * ee[kt]; st[kt][1] = st[kt][1] * ev[kt] + u[kt][1] * ee[kt]; }
        }
        LDS_BARRIER();
        if (prod) {
            if (n < T / 64) {
                int lrow = 16 * j4 + r; asm volatile("" : "+v"(lrow));
                s16x8 qfr[4], kfr[4][4];
#pragma unroll
                for (int ks = 0; ks < 4; ++ks) qfr[ks] = ldfrag(HG_QM(bb), 16 * j4, 32 * ks, lane);
#pragma unroll
                for (int si = 0; si < 4; ++si)
#pragma unroll
                    for (int ks = 0; ks < 4; ++ks) kfr[si][ks] = ldfrag(HG_KM(bb), 16 * si, 32 * ks, lane);
                SCHED_FENCE();
                f32x4 d[4];
#pragma unroll
                for (int si = 0; si < 4; ++si) d[si] = (f32x4){0.f, 0.f, 0.f, 0.f};
#pragma unroll
                for (int ks = 0; ks < 4; ++ks)
#pragma unroll
                    for (int si = 0; si < 4; ++si) d[si] = MFMA16(kfr[si][ks], qfr[ks], d[si]);
                SCHED_FENCE();
#pragma unroll
                for (int si = 0; si < 4; ++si) { const int s0 = 16 * si + 4 * q; float v[4];
#pragma unroll
                    for (int i = 0; i < 4; ++i) v[i] = (s0 + i <= lrow) ? d[si][i] : 0.f;
                    v2u o; o.x = pk2(v[0], v[1]); o.y = pk2(v[2], v[3]); *(LAS v2u*)(HG_P(bb) + lrow * LQ + s0) = o; }
            }
        } else if (c >= 0) {
            const LAS float* vn_ = HG_VEC(bb);
#pragma unroll
            for (int kt = 0; kt < 2; ++kt) { const f32x4 en = (n < T / 64) ? *(const LAS f32x4*)(vn_ + 16 * (2 * j4 + kt) + 4 * q) : (f32x4){1.f, 1.f, 1.f, 1.f};
#pragma unroll
                for (int dvt = 0; dvt < 2; ++dvt) { const f32x4 sv = st[kt][dvt] * en; v2u o; o.x = pk2(sv[0], sv[1]); o.y = pk2(sv[2], sv[3]);
                    *(LAS v2u*)(ST + (16 * dvt + r) * LP + 16 * (2 * j4 + kt) + 4 * q) = o; } }
        }
        LDS_BARRIER();
    }
    if (!prod) HG_STORE(T / 64 - 1);
#undef HG_STORE
#undef HG_LOAD
#undef HG_QM
#undef HG_KM
#undef HG_P
#undef HG_V
#undef HG_VEC
}

__device__ __forceinline__ void phase_post(const Args& a, unsigned char* ws, int l, int gw, int NGW, int lane) {
    bf16* PROJ = (bf16*)(ws + WS_PROJ); const bf16* SCR = (const bf16*)(ws + WS_SCR);
    const int c0 = lane * 8;
    {
        float snw0[8], snw1[8];
        { const float* p = a.in[I_SNW] + l * 1024;
#pragma unroll
          for (int e = 0; e < 8; ++e) { snw0[e] = p[c0 + e]; snw1[e] = p[512 + c0 + e]; } }
        for (int t = gw; t < M; t += 4 * NGW) {
            v4u ry0[4], rz0[4], ry1[4], rz1[4];
#pragma unroll
            for (int u = 0; u < 4; ++u) { const int tt = (t + u * NGW < M) ? t + u * NGW : t; const bf16* base = PROJ + (size_t)tt * PJ;
                ry0[u] = *(const GAS v4u*)(base + C_SX + c0); rz0[u] = *(const GAS v4u*)(base + C_SZ + c0); ry1[u] = *(const GAS v4u*)(base + C_SX + 512 + c0); rz1[u] = *(const GAS v4u*)(base + C_SZ + 512 + c0); }
#pragma unroll
            for (int u = 0; u < 4; ++u) { if (t + u * NGW < M) { bf16* base = PROJ + (size_t)(t + u * NGW) * PJ;
                float y0[8], z0[8], y1[8], z1[8]; unpack8(ry0[u], y0); unpack8(rz0[u], z0); unpack8(ry1[u], y1); unpack8(rz1[u], z1);
                float s0 = 0.f, s1 = 0.f;
#pragma unroll
                for (int e = 0; e < 8; ++e) { y0[e] *= siluf(z0[e]); y1[e] *= siluf(z1[e]); s0 += y0[e] * y0[e]; s1 += y1[e] * y1[e]; }
                const float r0 = __builtin_amdgcn_rsqf(wave_sum(s0) * (1.f / 512.f) + EPS), r1 = __builtin_amdgcn_rsqf(wave_sum(s1) * (1.f / 512.f) + EPS);
#pragma unroll
                for (int e = 0; e < 8; ++e) { y0[e] *= r0 * snw0[e]; y1[e] *= r1 * snw1[e]; }
                *(GAS v4u*)(base + C_SZ + c0) = pack8(y0); *(GAS v4u*)(base + C_SZ + 512 + c0) = pack8(y1); } }
        }
    }
    {
        float mnw[8], msk[8], cw[4][8], cbb[8];
#pragma unroll
        for (int e = 0; e < 8; ++e) { mnw[e] = a.in[I_MNW][l * 512 + c0 + e]; msk[e] = a.in[I_MSKIP][l * 512 + c0 + e]; cbb[e] = a.in[I_MCB][l * 512 + c0 + e];
#pragma unroll
            for (int j = 0; j < 4; ++j) cw[j][e] = a.in[I_MCW][(l * 4 + j) * 512 + c0 + e]; }
        for (int t = gw; t < M; t += 2 * NGW) {
            v4u rh[2], ro[2], rzz[2], rx[2][4];
#pragma unroll
            for (int u = 0; u < 2; ++u) { const int tt = (t + u * NGW < M) ? t + u * NGW : t; const bf16* base = PROJ + (size_t)tt * PJ; const int tl = tt % T;
                rh[u] = *(const GAS v4u*)(SCR + (size_t)tt * 1024 + c0); ro[u] = *(const GAS v4u*)(base + C_MO + c0); rzz[u] = *(const GAS v4u*)(base + C_MZ + c0);
#pragma unroll
                for (int j = 0; j < 4; ++j) rx[u][j] = (tl - 3 + j >= 0) ? *(const GAS v4u*)(PROJ + (size_t)(tt - 3 + j) * PJ + C_MX + c0) : (v4u){0u, 0u, 0u, 0u}; }
#pragma unroll
            for (int u = 0; u < 2; ++u) { if (t + u * NGW < M) { bf16* base = PROJ + (size_t)(t + u * NGW) * PJ;
                float hr[8], mo[8], mz[8]; unpack8(rh[u], hr); unpack8(ro[u], mo); unpack8(rzz[u], mz);
                float s = 0.f;
#pragma unroll
                for (int e = 0; e < 8; ++e) s += hr[e];
                s += __shfl_xor(s, 1); s += __shfl_xor(s, 2); s += __shfl_xor(s, 4); s += __shfl_xor(s, 8);
                const float mu = s * (1.f / 128.f); float q = 0.f;
#pragma unroll
                for (int e = 0; e < 8; ++e) { hr[e] -= mu; q += hr[e] * hr[e]; }
                q += __shfl_xor(q, 1); q += __shfl_xor(q, 2); q += __shfl_xor(q, 4); q += __shfl_xor(q, 8);
                const float rstd = __builtin_amdgcn_rsqf(q * (1.f / 128.f) + EPS);
                float mc[8];
#pragma unroll
                for (int e = 0; e < 8; ++e) mc[e] = cbb[e];
#pragma unroll
                for (int j = 0; j < 4; ++j) { float xj[8]; unpack8(rx[u][j], xj);
#pragma unroll
                    for (int e = 0; e < 8; ++e) mc[e] += cw[j][e] * xj[e]; }
                float y[8];
#pragma unroll
                for (int e = 0; e < 8; ++e) y[e] = (hr[e] * rstd * mnw[e] * sigm(mo[e]) + msk[e] * siluf(mc[e])) * siluf(mz[e]);
                *(GAS v4u*)(base + C_MZ + c0) = pack8(y); } }
        }
    }
    {
        float hnw[8];
#pragma unroll
        for (int e = 0; e < 8; ++e) hnw[e] = a.in[I_HNW][l * 512 + c0 + e];
        for (int t = gw; t < M; t += 4 * NGW) {
            v4u rr[4], rg[4];
#pragma unroll
            for (int u = 0; u < 4; ++u) { const int tt = (t + u * NGW < M) ? t + u * NGW : t; rr[u] = *(const GAS v4u*)(PROJ + (size_t)tt * PJ + C_GI + c0); rg[u] = *(const GAS v4u*)(PROJ + (size_t)tt * PJ + C_GZ + c0); }
#pragma unroll
            for (int u = 0; u < 4; ++u) { if (t + u * NGW < M) { float o[8], gz[8]; unpack8(rr[u], o); unpack8(rg[u], gz);
                float q = 0.f;
#pragma unroll
                for (int e = 0; e < 8; ++e) q += o[e] * o[e];
                q += __shfl_xor(q, 1); q += __shfl_xor(q, 2); q += __shfl_xor(q, 4); q += __shfl_xor(q, 8);
                const float rstd = __builtin_amdgcn_rsqf(q * (1.f / 128.f) + EPS);
#pragma unroll
                for (int e = 0; e < 8; ++e) o[e] = o[e] * rstd * hnw[e] * siluf(gz[e]);
                *(GAS v4u*)(PROJ + (size_t)(t + u * NGW) * PJ + C_GZ + c0) = pack8(o); } }
        }
    }
}
__device__ __forceinline__ void phase_final(float* X, const float* w, int gw, int NGW, int lane) {
    for (int m = gw; m < M; m += NGW) {
        GAS f32x4* xr = (GAS f32x4*)(X + (size_t)m * D) + lane; const GAS f32x4* wr = (const GAS f32x4*)w + lane;
        f32x4 v[4]; float s = 0.f;
#pragma unroll
        for (int j = 0; j < 4; ++j) { v[j] = xr[64 * j]; s += (v[j].x * v[j].x + v[j].y * v[j].y) + (v[j].z * v[j].z + v[j].w * v[j].w); }
        const float rstd = 1.0f / sqrtf(wave_sum(s) * (1.f / D) + EPS);
#pragma unroll
        for (int j = 0; j < 4; ++j) { const f32x4 ww = wr[64 * j]; xr[64 * j] = v[j] * rstd * ww; }
    }
}

constexpr int PH_PER_LAYER = 8, N_PHASES = DEPTH * PH_PER_LAYER + 1;
__device__ __forceinline__ unsigned char* fresh_ws() {
    typedef __attribute__((address_space(4))) const char cchar4;
    cchar4* ka = (cchar4*)__builtin_amdgcn_kernarg_segment_ptr();
    const unsigned long long raw_ = *(volatile __attribute__((address_space(4))) const unsigned long long*)(ka + __builtin_offsetof(Args, ws));
    return (unsigned char*)((__attribute__((address_space(1))) unsigned char*)raw_);
}
struct Ctx { int tid, lane, wave, G, bx, gw, NGW; };
template <int SUB>
__device__ __forceinline__ void run_phase(const Args& args, const int l, LAS unsigned char* lds, const Ctx c0, const int imask = 7) {
    Ctx c = c0; { int t_ = threadIdx.x; asm volatile("" : "+v"(t_)); c.tid = t_; c.lane = t_ & 63; }
    unsigned char* ws = fresh_ws();
    bf16* XN = (bf16*)(ws + WS_XN); bf16* PROJ = (bf16*)(ws + WS_PROJ);
    const float* Xin = (l == 0) ? args.in[I_X] : args.out;
    if constexpr (SUB == 8) {
        if (c.G != 256) phase_final(args.out, args.in[I_FNW], c.gw, c.NGW, c.lane);
    } else if constexpr (SUB == 0) {
        phase_weights(args, ws, l, lds, c.gw, c.NGW, c.wave, c.lane);
        if (l == 0 || c.G != 256) phase_norm(Xin, args.in[I_NORMW] + l * D, XN, c.gw, c.NGW, c.lane);
    } else if constexpr (SUB == 1) {
        pg8::Gemm g{XN, (const bf16*)(ws + WS_W1), D, D}; pg8::StaticOrder S; S.init(M, PJ, D, c.G, c.bx);
        pg8::EpiProj E{PROJ, PJ, (bf16*)(ws + WS_HALO), HALO_COLS, 0};
        pg8::gemm_phase<pg8::EpiProj, pg8::StaticOrder, true, true>(lds, g, S, E);
    } else if constexpr (SUB == 2) {
        for (int tile = c.bx; tile < M / 64; tile += c.G) phase_c0(args, ws, l, lds, tile, c.tid);
    } else if constexpr (SUB >= 10 && SUB <= 12) {
        for (int it = c.bx; it < 256; it += c.G) {
            if (SUB == 10 && it < 128) scan_ssd(args, ws, l, lds, it >> 5, (it >> 1) & 15, it & 1, c.tid);
            else if (SUB == 11 && it >= 128 && it < 192) scan_ml(args, ws, l, lds, (it - 128) >> 4, ((it - 128) >> 2) & 3, (it - 128) & 3, c.tid);
            else if (SUB == 12 && it >= 192) scan_hg(args, ws, l, lds, (it - 192) >> 4, ((it - 192) >> 2) & 3, (it - 192) & 3, c.tid);
        }
    } else if constexpr (SUB == 13) {
        phase_post(args, ws, l, c.gw, c.NGW, c.lane);
    } else if constexpr (SUB == 14) {
        phase_norm(Xin, args.in[I_NORMW] + l * D, XN, c.gw, c.NGW, c.lane);
    } else if constexpr (SUB == 3) {
        for (int u = c.bx; u < 256; u += c.G) {
            const int xcd = u & 7, slot = u >> 3;
            if (slot < 16) { if (imask & 1) scan_ssd(args, ws, l, lds, xcd >> 1, (xcd & 1) * 8 + (slot >> 1), slot & 1, c.tid); }
            else if (slot < 24) { const int gi = xcd * 2 + ((slot - 16) >> 2); if (imask & 2) scan_ml(args, ws, l, lds, gi >> 2, gi & 3, slot & 3, c.tid); }
            else { const int gi = xcd * 2 + ((slot - 24) >> 2); if (imask & 4) scan_hg(args, ws, l, lds, gi >> 2, gi & 3, slot & 3, c.tid); }
        }
    } else if constexpr (SUB == 4) {
        if (imask & 1) phase_post(args, ws, l, c.gw, c.NGW, c.lane);
        if (imask & 2) phase_norm(Xin, args.in[I_NORMW] + l * D, XN, c.gw, c.NGW, c.lane);
    } else if constexpr (SUB == 5) {
        pg8::Gemm g{XN, (const bf16*)(ws + WS_W2), D, D}; pg8::StaticOrder S; S.init(M, 3072, D, c.G, c.bx);
        pg8::EpiProj E{PROJ, PJ, nullptr, 0, 1};
        pg8::gemm_phase<pg8::EpiProj, pg8::StaticOrder, true, true>(lds, g, S, E);
    } else if constexpr (SUB == 6) {
        pg8::Gemm g{PROJ + C_SZ, (const bf16*)(ws + WS_WBR), PJ, 2048}; pg8::BranchOrder S; S.init(M, D, c.G, c.bx);
        pg8::EpiMerge E{XN, D, PROJ, PJ};
        pg8::gemm_phase<pg8::EpiMerge, pg8::BranchOrder, true, true>(lds, g, S, E);
    } else if constexpr (SUB == 7) {
        pg8::Gemm g{XN, (const bf16*)(ws + WS_WOUT), D, D}; pg8::StaticOrder S; S.init(M, D, D, c.G, c.bx);
        {
            const bool last = (l == DEPTH - 1);
            pg8::EpiResidNorm E{Xin, args.out, D, last ? args.in[I_FNW] : args.in[I_NORMW] + (l + 1) * D, XN, (unsigned*)(ws + WS_XBUF) + (size_t)l * M * 4,
                                (unsigned*)(ws + WS_CTL) + CW_PANEL + l * 4096, last ? 1 : 0, EPS};
            pg8::gemm_phase<pg8::EpiResidNorm, pg8::StaticOrder, false, true>(lds, g, S, E);
        }
    }
}
__device__ __forceinline__ Ctx make_ctx() {
    Ctx c; c.tid = threadIdx.x; c.lane = c.tid & 63; c.wave = __builtin_amdgcn_readfirstlane(c.tid >> 6);
    c.G = gridDim.x; c.bx = blockIdx.x;
    const int vcu = (c.G % 8 == 0) ? (c.bx % 8) * (c.G / 8) + c.bx / 8 : c.bx;
    c.gw = vcu * NWAVES + c.wave; c.NGW = c.G * NWAVES; return c;
}
template <int SUB>
__global__ void __launch_bounds__(NTHR, 2) fwd_single(Args args, int l) {
    extern __shared__ __attribute__((aligned(16))) unsigned char lds_raw[];
    LAS unsigned char* lds = (LAS unsigned char*)lds_raw;
    const Ctx c = make_ctx();
    run_phase<SUB>(args, l, lds, c);
}
#if !MK_PER_PHASE
__global__ void __launch_bounds__(NTHR, 2) fwd_all(Args args) {
    extern __shared__ __attribute__((aligned(16))) unsigned char lds_raw[];
    LAS unsigned char* lds = (LAS unsigned char*)lds_raw;
    const Ctx c = make_ctx();
    volatile LAS unsigned* MISC = (volatile LAS unsigned*)(lds + MISC_OFF);
    if (c.tid < 32) MISC[c.tid] = 0u;
    __syncthreads();
    const XcdBarrier bar = xcd_barrier_post((unsigned*)(fresh_ws() + WS_CTL) + CW_BAR, MISC + 8);
#pragma unroll 1
    for (int it = 0; it < DEPTH + (PROBE_K > 0 ? 1 : 0); ++it) {
        const bool probe = (PROBE_K > 0) && it == 0;
        const int l = (PROBE_K > 0) ? (it == 0 ? 0 : it - 1) : it;
        const int kmax = probe ? PROBE_K : 8;
        const int im = probe ? PROBE_IMASK : 7;
        if (0 < kmax) { run_phase<0>(args, l, lds, c); xcd_barrier(bar); }
        if (1 < kmax) { run_phase<1>(args, l, lds, c); xcd_barrier(bar); }
        if (2 < kmax) { run_phase<2>(args, l, lds, c); xcd_barrier(bar); }
        if (3 < kmax) { run_phase<3>(args, l, lds, c, im); xcd_barrier(bar); }
        if (4 < kmax) { run_phase<4>(args, l, lds, c, im); xcd_barrier(bar); }
        if (5 < kmax) { run_phase<5>(args, l, lds, c); xcd_barrier(bar); }
        if (6 < kmax) { run_phase<6>(args, l, lds, c); xcd_barrier(bar); }
        if (7 < kmax) { run_phase<7>(args, l, lds, c); if (l + 1 < DEPTH || c.G != 256) xcd_barrier(bar); }
    }
    if constexpr ((FMASK >> 8) & 1) run_phase<8>(args, 0, lds, c);
}
#endif

template <int SUB> static void launch_single(int grid, hipStream_t stream, const Args& a, int l) {
    static bool attr_done = false;
    if (!attr_done) { (void)hipFuncSetAttribute((const void*)fwd_single<SUB>, hipFuncAttributeMaxDynamicSharedMemorySize, LDS_BYTES); attr_done = true; }
    hipLaunchKernelGGL(fwd_single<SUB>, dim3(grid), dim3(NTHR), LDS_BYTES, stream, a, l);
}
extern "C" void kernel_launch(void* const* d_in, const int* in_sizes, int n_in, void* d_out, int out_size, void* d_ws, size_t ws_size, hipStream_t stream) {
    static int grid = 0;
    if (grid == 0) {
        if (n_in != 25 || in_sizes[0] != M * D || out_size != M * D || ws_size < WS_END) { fprintf(stderr, "kernel_launch: unexpected shapes (n_in %d, in0 %d, out %d, ws %zu)\n", n_in, n_in > 0 ? in_sizes[0] : -1, out_size, ws_size); grid = -1; return; }
        int dev = 0, cus = 0;
        if (hipGetDevice(&dev) != hipSuccess || hipDeviceGetAttribute(&cus, hipDeviceAttributeMultiprocessorCount, dev) != hipSuccess) { grid = -1; return; }
#if !MK_PER_PHASE
        int per_cu = 0;
        if (hipFuncSetAttribute((const void*)fwd_all, hipFuncAttributeMaxDynamicSharedMemorySize, LDS_BYTES) != hipSuccess) { fprintf(stderr, "kernel_launch: hipFuncSetAttribute failed\n"); grid = -1; return; }
        if (hipOccupancyMaxActiveBlocksPerMultiprocessor(&per_cu, (const void*)fwd_all, NTHR, LDS_BYTES) != hipSuccess || per_cu < 1)
            fprintf(stderr, "kernel_launch: occupancy query reports %d workgroups per CU\n", per_cu);
#endif
        (void)hipGetLastError();
        grid = cus;
    }
    if (grid < 0) return;
    Args a{};
    for (int i = 0; i < 25; ++i) a.in[i] = (const float*)d_in[i];
    a.out = (float*)d_out; a.ws = (unsigned char*)d_ws; a.ph_lo = 0; a.ph_hi = N_PHASES;
#if MK_PER_PHASE
#if PROBE_K > 0
    launch_single<0>(grid, stream, a, 0);
#endif
#if PROBE_K > 1
    launch_single<1>(grid, stream, a, 0);
#endif
#if PROBE_K > 2
    launch_single<2>(grid, stream, a, 0);
#endif
#if PROBE_K > 3
    launch_single<PROBE_SCAN>(grid, stream, a, 0);
#endif
#if PROBE_K > 4
    launch_single<PROBE_POST>(grid, stream, a, 0);
#endif
#if PROBE_K > 5
    launch_single<5>(grid, stream, a, 0);
#endif
#if PROBE_K > 6
    launch_single<6>(grid, stream, a, 0);
#endif
    for (int l = 0; l < DEPTH; ++l) {
        launch_single<0>(grid, stream, a, l); launch_single<1>(grid, stream, a, l); launch_single<2>(grid, stream, a, l); launch_single<3>(grid, stream, a, l);
        launch_single<4>(grid, stream, a, l); launch_single<5>(grid, stream, a, l); launch_single<6>(grid, stream, a, l); launch_single<7>(grid, stream, a, l);
    }
    launch_single<8>(grid, stream, a, 0);
#else
    (void)hipMemsetAsync((char*)d_ws + WS_CTL, 0, CTL_ZERO_BYTES, stream);
    hipLaunchKernelGGL(fwd_all, dim3(grid), dim3(NTHR), LDS_BYTES, stream, a);
#endif
    const hipError_t le = hipPeekAtLastError();
    if (le != hipSuccess) fprintf(stderr, "kernel_launch: launch failed: %s\n", hipGetErrorName(le));
}
```

```cpp
#include <hip/hip_runtime.h>
#include <cstdio>
#include <cstdint>
#include <cmath>

#ifndef C0SKIP
#define C0SKIP 0
#endif
#ifndef PROBE_SCAN
#define PROBE_SCAN 3
#endif
#ifndef PROBE_POST
#define PROBE_POST 4
#endif
#ifndef PROBE_IMASK
#define PROBE_IMASK 7
#endif
#ifndef PROBE_K
#define PROBE_K 0
#endif
#ifndef FMASK
#define FMASK 0x1ff
#endif
#ifndef FUSED_UNROLL_LAYERS
#define FUSED_UNROLL_LAYERS 0
#endif
#ifndef MK_PER_PHASE
#define MK_PER_PHASE 0
#endif

namespace pg8 {
#define PG8_LAS __attribute__((address_space(3)))
typedef unsigned short bf16_t;
typedef short bf16x8 __attribute__((ext_vector_type(8)));
typedef float f32x4 __attribute__((ext_vector_type(4)));
typedef unsigned u32x4 __attribute__((ext_vector_type(4)));
constexpr int BM = 256, BK = 64, HALF = 128, HTB = HALF * BK * 2  , STAGE_BYTES = 8 * HTB, NXCD = 8, WGM = 8;

__host__ __device__ __forceinline__ int lds_byte(int r, int c) { const int st = (r >> 4) * 2 + (c >> 5), rr = r & 15, cc = c & 31, ob = rr * 64 + cc * 2; return st * 1024 + (ob ^ (((ob >> 9) & 1) << 5)); }
__host__ __device__ __forceinline__ void stage_rc(int b, int& R, int& C) { const int st = b / 1024, sb = b % 1024, swz = sb ^ (((sb >> 9) & 1) << 5); R = (st >> 1) * 16 + swz / 64; C = (st & 1) * 32 + (swz % 64) / 2; }
__host__ __device__ __forceinline__ int perm32(int rho) { const int n = rho >> 4, i = rho & 15; return 8 * (i >> 2) + 4 * n + (i & 3); }

struct Unit { int pm, pn, ka, kb, nt, tag; };
struct Gemm { const bf16_t* A; const bf16_t* Bt; int lda, ldb; };

struct StaticOrder {
    int nM, nN, nwg, G, c, nt;
    __host__ __device__ void init(int M, int N, int K, int G_, int c_) { nM = M / BM; nN = N / BM; nwg = nM * nN; G = G_; c = c_; nt = K / BK; }
    __host__ __device__ void map(int wgid, int& pm, int& pn) const {
        { const int q = nwg / NXCD, r = nwg % NXCD, xcd = wgid % NXCD, off = wgid / NXCD; wgid = (xcd < r ? xcd * (q + 1) : r * (q + 1) + (xcd - r) * q) + off; }
        const int nig = WGM * nN, gid = wgid / nig, fm = gid * WGM, gsz = (nM - fm) < WGM ? (nM - fm) : WGM;
        pm = fm + ((wgid % nig) % gsz); pn = (wgid % nig) / gsz;
    }
    __host__ __device__ bool next(int i, Unit& u) const {
        const long L = (long)i * G + c; if (L >= nwg) return false;
        map((int)L, u.pm, u.pn); u.ka = 0; u.kb = 0; u.nt = nt; u.tag = 0; return true;
    }
    __device__ __forceinline__ void a_ready(const Unit&) const {}
    __device__ __forceinline__ void done(const Unit&) const {}
};
struct BranchOrder {
    StaticOrder so;
    __host__ __device__ void init(int M, int N, int G_, int c_) { so.init(M, N, 1024, G_, c_); }
    __host__ __device__ bool next(int i, Unit& u) const {
        const int j = i / 3, pos = i - 3 * j, rot = (so.c >> 3) % 3; int br = pos + rot; if (br >= 3) br -= 3;
        const long L = (long)j * so.G + so.c; if (L >= so.nwg) return false;
        so.map((int)L, u.pm, u.pn);
        const int koff = br == 0 ? 0 : (br == 1 ? 1024 : 1536);
        u.ka = koff * 2; u.kb = koff * 2; u.nt = br == 0 ? 16 : 8; int brn = br + 1; if (brn >= 3) brn -= 3; u.tag = br | (pos << 4) | (brn << 8); return true;
    }
    __device__ __forceinline__ void a_ready(const Unit&) const {}
    __device__ __forceinline__ void done(const Unit&) const {}
};

typedef __bf16 pbf16x2 __attribute__((ext_vector_type(2)));
typedef float pf32x2 __attribute__((ext_vector_type(2)));
__device__ __forceinline__ unsigned cvt_pk_bf16(float lo, float hi) { const pf32x2 v = {lo, hi}; return __builtin_bit_cast(unsigned, __builtin_convertvector(v, pbf16x2)); }
__device__ __forceinline__ float bflo(unsigned w) { return __uint_as_float(w << 16); }
__device__ __forceinline__ float bfhi(unsigned w) { return __uint_as_float(w & 0xffff0000u); }
__device__ __forceinline__ float sigmoidf_(float x) { return __builtin_amdgcn_rcpf(1.0f + __expf(-x)); }

struct EpiProj {
    static constexpr bool PERM = true, AFTER_DRAIN = false, KEEP_ACC = false;
    bf16_t* O; int ldc; bf16_t* halo; int halo_cols; int act;
    __device__ __forceinline__ void operator()(const f32x4 (&acc)[2][2][4][2], const Unit& u, int wr, int wc, int fr, int fq) const {
        const int row0 = u.pm * BM + wr * 64 + fr, col0 = u.pn * BM + wc * 32 + 8 * fq;
        const bool do_halo = halo != nullptr && (u.pn * BM < halo_cols) && fr >= 13;
#pragma unroll
        for (int ai = 0; ai < 2; ++ai)
#pragma unroll
            for (int m = 0; m < 4; ++m) { const int row = row0 + ai * HALF + m * 16; bf16_t* rowp = O + (size_t)row * ldc + col0;
#pragma unroll
                for (int bj = 0; bj < 2; ++bj) { f32x4 v0 = acc[ai][bj][m][0], v1 = acc[ai][bj][m][1];
                    if (act == 1) {
#pragma unroll
                        for (int e = 0; e < 4; ++e) { v0[e] = sigmoidf_(v0[e]); v1[e] = sigmoidf_(v1[e]); } }
                    u32x4 w; w.x = cvt_pk_bf16(v0[0], v0[1]); w.y = cvt_pk_bf16(v0[2], v0[3]); w.z = cvt_pk_bf16(v1[0], v1[1]); w.w = cvt_pk_bf16(v1[2], v1[3]);
                    *(u32x4*)(rowp + bj * HALF) = w;
                    if (m == 3 && do_halo) *(u32x4*)(halo + ((size_t)(row >> 6) * 3 + (fr - 13)) * halo_cols + col0 + bj * HALF) = w; } }
    }
};
struct EpiMerge {
    static constexpr bool PERM = true, AFTER_DRAIN = false, KEEP_ACC = true;
    bf16_t* O; int ldc; const bf16_t* G; int ldg;
    __device__ __forceinline__ void operator()(f32x4 (&acc)[2][2][4][2], const Unit& u, int wr, int wc, int fr, int fq) const {
        const int row0 = u.pm * BM + wr * 64 + fr, col0 = u.pn * BM + wc * 32 + 8 * fq;
        const int br = u.tag & 15, pos = (u.tag >> 4) & 15, brn = (u.tag >> 8) & 15;
        const float eps_ = 9.094947017729282e-13f;
#pragma unroll
        for (int ai = 0; ai < 2; ++ai)
#pragma unroll
            for (int mh = 0; mh < 2; ++mh) {
                u32x4 gq[2][2], nq[2][2];
#pragma unroll
                for (int m2 = 0; m2 < 2; ++m2) { const int row = row0 + ai * HALF + (2 * mh + m2) * 16;
#pragma unroll
                    for (int bj = 0; bj < 2; ++bj) { gq[m2][bj] = *(const u32x4*)(G + (size_t)row * ldg + br * 1024 + col0 + bj * HALF);
                        nq[m2][bj] = (pos < 2) ? *(const u32x4*)(G + (size_t)row * ldg + brn * 1024 + col0 + bj * HALF) : (u32x4){0x3f803f80u, 0x3f803f80u, 0x3f803f80u, 0x3f803f80u}; } }
                asm volatile("" ::: "memory");
#pragma unroll
                for (int m2 = 0; m2 < 2; ++m2) { const int m = 2 * mh + m2; const int row = row0 + ai * HALF + m * 16; bf16_t* rowp = O + (size_t)row * ldc + col0;
#pragma unroll
                    for (int bj = 0; bj < 2; ++bj) { f32x4 v0 = acc[ai][bj][m][0], v1 = acc[ai][bj][m][1];
                        const u32x4 g = gq[m2][bj], nx = nq[m2][bj];
                        float sc[8] = {bflo(g.x), bfhi(g.x), bflo(g.y), bfhi(g.y), bflo(g.z), bfhi(g.z), bflo(g.w), bfhi(g.w)};
                        if (pos < 2) { const float sn[8] = {bflo(nx.x), bfhi(nx.x), bflo(nx.y), bfhi(nx.y), bflo(nx.z), bfhi(nx.z), bflo(nx.w), bfhi(nx.w)};
#pragma unroll
                            for (int e = 0; e < 8; ++e) sc[e] = fmaxf(sc[e], eps_) * __builtin_amdgcn_rcpf(fmaxf(sn[e], eps_)); }
                        else {
#pragma unroll
                            for (int e = 0; e < 8; ++e) sc[e] = fmaxf(sc[e], eps_); }
                        v0[0] *= sc[0]; v0[1] *= sc[1]; v0[2] *= sc[2]; v0[3] *= sc[3]; v1[0] *= sc[4]; v1[1] *= sc[5]; v1[2] *= sc[6]; v1[3] *= sc[7];
                        if (pos < 2) { acc[ai][bj][m][0] = v0; acc[ai][bj][m][1] = v1; }
                        else { u32x4 w; w.x = cvt_pk_bf16(v0[0], v0[1]); w.y = cvt_pk_bf16(v0[2], v0[3]); w.z = cvt_pk_bf16(v1[0], v1[1]); w.w = cvt_pk_bf16(v1[2], v1[3]);
                            *(u32x4*)(rowp + bj * HALF) = w; acc[ai][bj][m][0] = (f32x4){0.f, 0.f, 0.f, 0.f}; acc[ai][bj][m][1] = (f32x4){0.f, 0.f, 0.f, 0.f}; } } }
            }
    }
};
struct EpiResid {
    static constexpr bool PERM = false, AFTER_DRAIN = false, KEEP_ACC = false;
    const float* base; float* out; int ldc;
    __device__ __forceinline__ void operator()(const f32x4 (&acc)[2][2][4][2], const Unit& u, int wr, int wc, int fr, int fq) const {
        const int row0 = u.pm * BM + wr * 64 + fr, col0 = u.pn * BM + wc * 32 + 4 * fq;
#pragma unroll
        for (int ai = 0; ai < 2; ++ai)
#pragma unroll
            for (int mh = 0; mh < 2; ++mh) {
                f32x4 bs[2][2][2];
#pragma unroll
                for (int m2 = 0; m2 < 2; ++m2) { const size_t off = (size_t)(row0 + ai * HALF + (2 * mh + m2) * 16) * ldc + col0;
#pragma unroll
                    for (int bj = 0; bj < 2; ++bj)
#pragma unroll
                        for (int n = 0; n < 2; ++n) bs[m2][bj][n] = *(const f32x4*)(base + off + bj * HALF + n * 16); }
                asm volatile("" ::: "memory");
#pragma unroll
                for (int m2 = 0; m2 < 2; ++m2) { const size_t off = (size_t)(row0 + ai * HALF + (2 * mh + m2) * 16) * ldc + col0;
#pragma unroll
                    for (int bj = 0; bj < 2; ++bj)
#pragma unroll
                        for (int n = 0; n < 2; ++n) *(f32x4*)(out + off + bj * HALF + n * 16) = bs[m2][bj][n] + acc[ai][bj][2 * mh + m2][n]; }
            }
    }
};
struct EpiResidNorm {
    static constexpr bool PERM = true, AFTER_DRAIN = true, KEEP_ACC = false;
    const float* base; float* out; int ldc; const float* w; bf16_t* xn; unsigned* xbuf; unsigned* cnt; int mode; float eps;
    __device__ __forceinline__ void fused(f32x4 (&acc)[2][2][4][2], const Unit& u, int wr, int wc, int fr, int fq, PG8_LAS unsigned char* lds, int wid, int lane) const {
        PG8_LAS float* P = (PG8_LAS float*)lds;
        PG8_LAS float* S = (PG8_LAS float*)(lds + 4096);
        int row0 = u.pm * BM + wr * 64 + fr, col0 = u.pn * BM + wc * 32 + 8 * fq;
        asm volatile("" : "+v"(row0), "+v"(col0));
#pragma unroll
        for (int ai = 0; ai < 2; ++ai)
#pragma unroll
            for (int m = 0; m < 4; ++m) {
                f32x4 bs[2][2]; const unsigned off = (unsigned)(row0 + ai * HALF + m * 16) * (unsigned)ldc + (unsigned)col0;
                if (mode == 1) {
                    const bf16_t* b16 = (const bf16_t*)base + (unsigned)(row0 + ai * HALF + m * 16) * 2048u + (unsigned)col0;
#pragma unroll
                    for (int bj = 0; bj < 2; ++bj) { const u32x4 rb = *(const u32x4*)(b16 + bj * HALF);
                        bs[bj][0] = (f32x4){bflo(rb.x), bfhi(rb.x), bflo(rb.y), bfhi(rb.y)}; bs[bj][1] = (f32x4){bflo(rb.z), bfhi(rb.z), bflo(rb.w), bfhi(rb.w)}; }
                } else {
#pragma unroll
                for (int bj = 0; bj < 2; ++bj)
#pragma unroll
                    for (int n = 0; n < 2; ++n) bs[bj][n] = *(const f32x4*)(base + off + bj * HALF + n * 4);
                }
#pragma unroll
                for (int bj = 0; bj < 2; ++bj)
#pragma unroll
                    for (int n = 0; n < 2; ++n) acc[ai][bj][m][n] += bs[bj][n];
                asm volatile("" : "+v"(acc[ai][0][m][0]), "+v"(acc[ai][0][m][1]), "+v"(acc[ai][1][m][0]), "+v"(acc[ai][1][m][1]) :: "memory");
            }
#pragma unroll
        for (int ai = 0; ai < 2; ++ai)
#pragma unroll
            for (int m = 0; m < 4; ++m) { float sq = 0.f;
#pragma unroll
                for (int bj = 0; bj < 2; ++bj)
#pragma unroll
                    for (int n = 0; n < 2; ++n) { const f32x4 x = acc[ai][bj][m][n]; sq += (x[0] * x[0] + x[1] * x[1]) + (x[2] * x[2] + x[3] * x[3]); }
                sq += __shfl_xor(sq, 16); sq += __shfl_xor(sq, 32);
                if (fq == 0) P[(ai * HALF + wr * 64 + m * 16 + fr) * 4 + wc] = sq; }
        asm volatile("s_waitcnt lgkmcnt(0)" ::: "memory"); __builtin_amdgcn_s_barrier(); asm volatile("" ::: "memory");
        const int row = wid * 32 + (lane & 31);
        if (lane < 32) { const float t = (P[row * 4 + 0] + P[row * 4 + 1]) + (P[row * 4 + 2] + P[row * 4 + 3]);
            __hip_atomic_store(xbuf + ((unsigned)(u.pm * BM + row) * 4u + (unsigned)u.pn), __float_as_uint(t), __ATOMIC_RELAXED, __HIP_MEMORY_SCOPE_AGENT); }
        asm volatile("s_waitcnt vmcnt(0)" ::: "memory");
        if (lane == 0) __hip_atomic_fetch_add(cnt + 64 * u.pm, 1u, __ATOMIC_RELAXED, __HIP_MEMORY_SCOPE_AGENT);
        if (wid == 0) { unsigned sp = 0u;
            while ((unsigned)__builtin_amdgcn_readfirstlane(__hip_atomic_load(cnt + 64 * u.pm, __ATOMIC_RELAXED, __HIP_MEMORY_SCOPE_AGENT)) < 32u) { __builtin_amdgcn_s_sleep(2); if (++sp > (1u << 22)) break; }
            __builtin_amdgcn_fence(__ATOMIC_ACQUIRE, "agent"); }
        asm volatile("s_waitcnt vmcnt(0) lgkmcnt(0)" ::: "memory"); __builtin_amdgcn_s_barrier(); asm volatile("" ::: "memory");
        if (lane < 32) { const unsigned* sl = xbuf + (unsigned)(u.pm * BM + row) * 4u; float t = 0.f;
#pragma unroll
            for (int k = 0; k < 4; ++k) t += __uint_as_float(__hip_atomic_load(sl + k, __ATOMIC_RELAXED, __HIP_MEMORY_SCOPE_AGENT));
            S[row] = __builtin_amdgcn_rsqf(t * (1.0f / 1024.0f) + eps); }
        asm volatile("s_waitcnt lgkmcnt(0)" ::: "memory"); __builtin_amdgcn_s_barrier(); asm volatile("" ::: "memory");
        f32x4 wv[2][2];
#pragma unroll
        for (int bj = 0; bj < 2; ++bj)
#pragma unroll
            for (int n = 0; n < 2; ++n) wv[bj][n] = *(const f32x4*)(w + col0 + bj * HALF + n * 4);
#pragma unroll
        for (int ai = 0; ai < 2; ++ai)
#pragma unroll
            for (int m = 0; m < 4; ++m) { const int r = ai * HALF + wr * 64 + m * 16 + fr; const float rs = S[r]; const unsigned off = (unsigned)(u.pm * BM + r) * (unsigned)ldc + (unsigned)col0;
#pragma unroll
                for (int bj = 0; bj < 2; ++bj) { const f32x4 x0 = acc[ai][bj][m][0], x1 = acc[ai][bj][m][1]; const f32x4 y0 = x0 * rs * wv[bj][0], y1 = x1 * rs * wv[bj][1];
                    if (mode == 1) { *(f32x4*)(out + off + bj * HALF) = y0; *(f32x4*)(out + off + bj * HALF + 4) = y1; }
                    else {
                        u32x4 px; px.x = cvt_pk_bf16(x0[0], x0[1]); px.y = cvt_pk_bf16(x0[2], x0[3]); px.z = cvt_pk_bf16(x1[0], x1[1]); px.w = cvt_pk_bf16(x1[2], x1[3]);
                        *(u32x4*)((bf16_t*)out + (unsigned)(u.pm * BM + r) * 2048u + (unsigned)col0 + bj * HALF) = px;
                        u32x4 pkd; pkd.x = cvt_pk_bf16(y0[0], y0[1]); pkd.y = cvt_pk_bf16(y0[2], y0[3]); pkd.z = cvt_pk_bf16(y1[0], y1[1]); pkd.w = cvt_pk_bf16(y1[2], y1[3]);
                        *(u32x4*)(xn + off + bj * HALF) = pkd; } } }
    }
};

template <class Epi, class Sched, bool ALIGN_EPI = false, bool SP2 = false>
__device__ __forceinline__ void gemm_phase(PG8_LAS unsigned char* lds, const Gemm g, const Sched& S, const Epi& E) {
    int tid_ = threadIdx.x; asm volatile("" : "+v"(tid_));
    const int tid = tid_, wid = __builtin_amdgcn_readfirstlane(tid >> 6), lane = tid & 63, wr = wid >> 2, wc = wid & 3, fr = lane & 15, fq = lane >> 4;
    const int lda = g.lda, ldb = g.ldb;
    unsigned voffA[2], voffB[2];
#pragma unroll
    for (int i = 0; i < 2; ++i) { int R, C; stage_rc(tid * 16 + i * 8192, R, C); const int Rb = Epi::PERM ? ((R & ~31) + perm32(R & 31)) : R;
        voffA[i] = (unsigned)(R * lda + C) * 2u; voffB[i] = (unsigned)(Rb * ldb + C) * 2u; }
    const size_t kstep = (size_t)(BK * 2);
    const size_t hstepA = (size_t)HALF * lda * 2, hstepB = (size_t)HALF * ldb * 2;
    const size_t tstepA = 2 * hstepA, tstepB = 2 * hstepB;
    const unsigned ldsw = (unsigned)wid * 1024u;
    const int aoff = lds_byte(wr * 64 + fr, fq * 8), boff = lds_byte(wc * 32 + fr, fq * 8);
#define PG8_SA(b, h) (((b) * 2 + (h)) * HTB)
#define PG8_SB(b, h) ((4 + (b) * 2 + (h)) * HTB)
#define PG8_STAGE(bufoff, gbase, voff) do { _Pragma("unroll") for (int _i = 0; _i < 2; ++_i) \
        __builtin_amdgcn_global_load_lds((const unsigned*)((const char*)(gbase) + (voff)[_i]), (PG8_LAS unsigned*)(lds + (bufoff) + ldsw + _i * 8192), 16, 0, 0); } while (0)
#define PG8_LDA(dst, b, h) do { _Pragma("unroll") for (int m = 0; m < 4; ++m) _Pragma("unroll") for (int k = 0; k < 2; ++k) dst[m][k] = *(const PG8_LAS bf16x8*)(lds + PG8_SA(b, h) + aoff + m * 2048 + k * 1024); } while (0)
#define PG8_LDB(dst, b, h) do { _Pragma("unroll") for (int n = 0; n < 2; ++n) _Pragma("unroll") for (int k = 0; k < 2; ++k) dst[n][k] = *(const PG8_LAS bf16x8*)(lds + PG8_SB(b, h) + boff + n * 2048 + k * 1024); } while (0)
#define PG8_MMA(ai, bj, At, Bt) do { __builtin_amdgcn_s_setprio(1); _Pragma("unroll") for (int m = 0; m < 4; ++m) _Pragma("unroll") for (int n = 0; n < 2; ++n) _Pragma("unroll") for (int k = 0; k < 2; ++k) \
        acc[ai][bj][m][n] = __builtin_amdgcn_mfma_f32_16x16x32_bf16(Bt[n][k], At[m][k], acc[ai][bj][m][n], 0, 0, 0); __builtin_amdgcn_s_setprio(0); } while (0)
#define PG8_WAIT_V(n) asm volatile("s_waitcnt vmcnt(" #n ")" ::: "memory")
#define PG8_WAIT_L(n) asm volatile("s_waitcnt lgkmcnt(" #n ")" ::: "memory")
#define PG8_BAR __builtin_amdgcn_s_barrier()
#define PG8_SCHED __builtin_amdgcn_sched_barrier(0)
    Unit cur, nxt; int ui = 0;
    if (!S.next(0, cur)) return;
    f32x4 acc[2][2][4][2];
#pragma unroll
    for (int a = 0; a < 2; ++a)
#pragma unroll
        for (int b = 0; b < 2; ++b)
#pragma unroll
            for (int m = 0; m < 4; ++m)
#pragma unroll
                for (int n = 0; n < 2; ++n) acc[a][b][m][n] = (f32x4){0.f, 0.f, 0.f, 0.f};
    bf16x8 At[4][2], B0[2][2], B1[2][2];
    const char* cA = (const char*)g.A + (size_t)cur.pm * tstepA + cur.ka; const char* cB = (const char*)g.Bt + (size_t)cur.pn * tstepB + cur.kb;
    S.a_ready(cur);
    if constexpr (SP2) {
        PG8_STAGE(PG8_SB(0, 0), cB, voffB); PG8_STAGE(PG8_SB(0, 1), cB + hstepB, voffB); PG8_STAGE(PG8_SA(0, 0), cA, voffA); PG8_STAGE(PG8_SA(0, 1), cA + hstepA, voffA);
        if (wr == 1) PG8_BAR;
        PG8_WAIT_V(2); PG8_BAR;
        PG8_STAGE(PG8_SB(1, 0), cB + kstep, voffB); PG8_STAGE(PG8_SA(1, 0), cA + kstep, voffA); PG8_STAGE(PG8_SB(1, 1), cB + hstepB + kstep, voffB);
        PG8_WAIT_V(6); PG8_BAR;
    } else {
        PG8_STAGE(PG8_SB(0, 0), cB, voffB); PG8_STAGE(PG8_SA(0, 0), cA, voffA); PG8_STAGE(PG8_SB(0, 1), cB + hstepB, voffB); PG8_STAGE(PG8_SA(0, 1), cA + hstepA, voffA);
        if (wr == 1) PG8_BAR;
        PG8_WAIT_V(4); PG8_BAR;
        PG8_STAGE(PG8_SB(1, 0), cB + kstep, voffB); PG8_STAGE(PG8_SA(1, 0), cA + kstep, voffA); PG8_STAGE(PG8_SB(1, 1), cB + hstepB + kstep, voffB);
        PG8_WAIT_V(6); PG8_BAR;
    }
    for (;;) {
        const bool has_next = S.next(ui + 1, nxt);
        const char* nA = has_next ? (const char*)g.A + (size_t)nxt.pm * tstepA + nxt.ka : cA; const char* nB = has_next ? (const char*)g.Bt + (size_t)nxt.pn * tstepB + nxt.kb : cB;
        const int nt = cur.nt;
        for (int t = 0; t < nt; t += 2) {
            const bool last = (t == nt - 2);
            const char* a1 = cA + (size_t)(t + 1) * kstep;
            const char* a2 = last ? nA : cA + (size_t)(t + 2) * kstep; const char* b2 = last ? nB : cB + (size_t)(t + 2) * kstep;
            const char* a3 = a2 + kstep; const char* b3 = b2 + kstep;
            if (last && has_next) S.a_ready(nxt);
            if constexpr (SP2) {
            PG8_LDB(B0, 0, 0); PG8_LDB(B1, 0, 1); PG8_SCHED; PG8_LDA(At, 0, 0); PG8_STAGE(PG8_SA(1, 1), a1 + hstepA, voffA);
            PG8_WAIT_V(8); PG8_WAIT_L(0); PG8_BAR; PG8_MMA(0, 0, At, B0); PG8_MMA(0, 1, At, B1); PG8_BAR; PG8_SCHED;
            PG8_LDA(At, 0, 1); PG8_STAGE(PG8_SB(0, 0), b2, voffB); PG8_STAGE(PG8_SB(0, 1), b2 + hstepB, voffB); PG8_STAGE(PG8_SA(0, 0), a2, voffA);
            PG8_WAIT_V(8); PG8_WAIT_L(0); PG8_BAR; PG8_MMA(1, 0, At, B0); PG8_MMA(1, 1, At, B1); PG8_BAR; PG8_SCHED;
            PG8_LDB(B0, 1, 0); PG8_LDB(B1, 1, 1); PG8_SCHED; PG8_LDA(At, 1, 0); PG8_STAGE(PG8_SA(0, 1), a2 + hstepA, voffA);
            PG8_WAIT_V(8); PG8_WAIT_L(0); PG8_BAR; PG8_MMA(0, 0, At, B0); PG8_MMA(0, 1, At, B1); PG8_BAR; PG8_SCHED;
            PG8_LDA(At, 1, 1); PG8_STAGE(PG8_SB(1, 0), b3, voffB); PG8_STAGE(PG8_SB(1, 1), b3 + hstepB, voffB); PG8_STAGE(PG8_SA(1, 0), a3, voffA);
            PG8_WAIT_V(8); PG8_WAIT_L(0); PG8_BAR; PG8_MMA(1, 0, At, B0); PG8_MMA(1, 1, At, B1); PG8_BAR; PG8_SCHED;
            } else {
            PG8_LDB(B0, 0, 0); PG8_SCHED; PG8_LDA(At, 0, 0); PG8_STAGE(PG8_SA(1, 1), a1 + hstepA, voffA);
            PG8_WAIT_L(8); PG8_BAR; PG8_WAIT_L(0); PG8_MMA(0, 0, At, B0); PG8_BAR; PG8_SCHED;
            PG8_LDB(B1, 0, 1); PG8_STAGE(PG8_SB(0, 0), b2, voffB);
            PG8_BAR; PG8_WAIT_L(0); PG8_MMA(0, 1, At, B1); PG8_BAR;
            PG8_LDA(At, 0, 1); PG8_STAGE(PG8_SA(0, 0), a2, voffA);
            PG8_BAR; PG8_WAIT_L(0); PG8_MMA(1, 0, At, B0); PG8_BAR; PG8_SCHED;
            PG8_STAGE(PG8_SB(0, 1), b2 + hstepB, voffB);
            PG8_WAIT_V(6); PG8_BAR; PG8_MMA(1, 1, At, B1); PG8_BAR;
            PG8_LDB(B0, 1, 0); PG8_SCHED; PG8_LDA(At, 1, 0); PG8_STAGE(PG8_SA(0, 1), a2 + hstepA, voffA);
            PG8_WAIT_L(8); PG8_BAR; PG8_WAIT_L(0); PG8_MMA(0, 0, At, B0); PG8_BAR; PG8_SCHED;
            PG8_LDB(B1, 1, 1); PG8_STAGE(PG8_SB(1, 0), b3, voffB);
            PG8_BAR; PG8_WAIT_L(0); PG8_MMA(0, 1, At, B1); PG8_BAR;
            PG8_LDA(At, 1, 1); PG8_STAGE(PG8_SA(1, 0), a3, voffA);
            PG8_BAR; PG8_WAIT_L(0); PG8_MMA(1, 0, At, B0); PG8_BAR; PG8_SCHED;
            PG8_STAGE(PG8_SB(1, 1), b3 + hstepB, voffB);
            PG8_WAIT_V(6); PG8_BAR; PG8_MMA(1, 1, At, B1); PG8_BAR;
            }
        }
        if constexpr (ALIGN_EPI) { if (wr == 0) PG8_BAR; }
        if constexpr (!Epi::AFTER_DRAIN) { E(acc, cur, wr, wc, fr, fq); S.done(cur); }
        if (!has_next) break;
        if (!Epi::KEEP_ACC) {
#pragma unroll
        for (int a = 0; a < 2; ++a)
#pragma unroll
            for (int b = 0; b < 2; ++b)
#pragma unroll
                for (int m = 0; m < 4; ++m)
#pragma unroll
                    for (int n = 0; n < 2; ++n) acc[a][b][m][n] = (f32x4){0.f, 0.f, 0.f, 0.f};
        }
        cur = nxt; cA = nA; cB = nB; ++ui;
        if constexpr (ALIGN_EPI) { if (wr == 1) PG8_BAR; }
    }
    PG8_WAIT_V(0);
    if constexpr (!ALIGN_EPI) { if (wr == 0) PG8_BAR; }
    PG8_BAR;
    if constexpr (Epi::AFTER_DRAIN) { E.fused(acc, cur, wr, wc, fr, fq, lds, wid, lane); S.done(cur); }
#undef PG8_SA
#undef PG8_SB
#undef PG8_STAGE
#undef PG8_LDA
#undef PG8_LDB
#undef PG8_MMA
#undef PG8_WAIT_V
#undef PG8_WAIT_L
#undef PG8_BAR
#undef PG8_SCHED
}
}

constexpr int NWAVES = 8, NTHR = 512;
constexpr int BATCH = 4, T = 4096, D = 1024, M = BATCH * T, DEPTH = 2;
constexpr int N_IN = 9232;
constexpr float EPS = 1e-6f;
constexpr int PJ = 6144;
constexpr int C_SX = 0, C_SB = 1024, C_SC = 1280, C_MX = 1536, C_MO = 2048, C_GQ = 2560, C_GF = 3072, C_GI = 3584, C_SZ = 4096, C_MZ = 5120, C_GZ = 5632;
constexpr int HALO_COLS = 1536;
constexpr int O_SX = 0, O_SB = 1024, O_SC = 1280, O_DT = 1536, O_SZ = 1552, O_MX = 2576, O_MO = 3088, O_MZ = 3600, O_GQ = 4112, O_GF = 4624, O_GI = 5136, O_GZ = 5648, O_GATE = 6160;
__host__ __device__ __forceinline__ int orig_col(int n) {
    if (n < 1536) return n;
    if (n < 2048) return O_MX + (n - 1536);
    if (n < 2560) return O_MO + (n - 2048);
    if (n < 3072) return O_GQ + (n - 2560);
    if (n < 3584) return O_GF + (n - 3072);
    if (n < 4096) return O_GI + (n - 3584);
    if (n < 5120) return O_SZ + (n - 4096);
    if (n < 5632) return O_MZ + (n - 5120);
    return O_GZ + (n - 5632);
}
constexpr size_t MiB = 1u << 20;
constexpr size_t WS_CTL = 0, CTL_ZERO_BYTES = 64 * 1024;
constexpr size_t WS_W1 = 1 * MiB;
constexpr size_t WS_W2 = 13 * MiB;
constexpr size_t WS_WBR = 19 * MiB;
constexpr size_t WS_WOUT = 23 * MiB;
constexpr size_t WS_WDT = 25 * MiB;
constexpr size_t WS_WQKV = 25 * MiB + 64 * 1024;
constexpr size_t WS_GIF = 25 * MiB + 448 * 1024;
constexpr size_t WS_HALO = 26 * MiB;
constexpr size_t WS_XBUF = 28 * MiB + 512 * 1024;
constexpr size_t WS_SC64A = 64 * 1024;
constexpr size_t WS_SC64B = 25 * MiB + 512 * 1024;
constexpr size_t WS_MLC = 64 * 1024 + 512 * 1024;
constexpr size_t WS_MLP = 28 * MiB + 256 * 1024;
constexpr size_t WS_DT = 29 * MiB;
constexpr size_t WS_IF = 30 * MiB;
constexpr size_t WS_HGV = 30 * MiB + 512 * 1024;
constexpr size_t WS_XN = 32 * MiB;
constexpr size_t WS_SCR = 64 * MiB;
constexpr size_t WS_PROJ = 96 * MiB;
constexpr size_t WS_END = 288 * MiB;
constexpr int CW_PANEL = 8192;
constexpr int CW_BAR = 1024;

constexpr int LDS_BYTES = 163840;
constexpr int MISC_OFF = 159744;

#define GAS __attribute__((address_space(1)))
#define LAS __attribute__((address_space(3)))
typedef unsigned short bf16;
typedef unsigned v4u __attribute__((ext_vector_type(4)));
typedef unsigned v2u __attribute__((ext_vector_type(2)));
typedef float f32x4 __attribute__((ext_vector_type(4)));
#define LDS_WAIT() asm volatile("s_waitcnt lgkmcnt(0)" ::: "memory")
#define LDS_BARRIER() do { asm volatile("s_waitcnt lgkmcnt(0)" ::: "memory"); __builtin_amdgcn_s_barrier(); asm volatile("" ::: "memory"); } while (0)
#define VM_WAIT() asm volatile("s_waitcnt vmcnt(0)" ::: "memory")
#define SCHED_FENCE() __builtin_amdgcn_sched_barrier(0)
typedef __bf16 hbf16x2 __attribute__((ext_vector_type(2)));
typedef float hf32x2 __attribute__((ext_vector_type(2)));
__device__ __forceinline__ unsigned pk2(float lo, float hi) { const hf32x2 v = {lo, hi}; return __builtin_bit_cast(unsigned, __builtin_convertvector(v, hbf16x2)); }
__device__ __forceinline__ unsigned f2bf(float f) { return pk2(f, 0.f) & 0xffffu; }
__device__ __forceinline__ float bf2f(unsigned short h) { return __uint_as_float((unsigned)h << 16); }
__device__ __forceinline__ float blo(unsigned w) { return __uint_as_float(w << 16); }
__device__ __forceinline__ float bhi(unsigned w) { return __uint_as_float(w & 0xffff0000u); }
__device__ __forceinline__ void unpack8(const v4u w, float (&f)[8]) { f[0] = blo(w.x); f[1] = bhi(w.x); f[2] = blo(w.y); f[3] = bhi(w.y); f[4] = blo(w.z); f[5] = bhi(w.z); f[6] = blo(w.w); f[7] = bhi(w.w); }
__device__ __forceinline__ v4u pack8(const float (&f)[8]) { v4u w; w.x = pk2(f[0], f[1]); w.y = pk2(f[2], f[3]); w.z = pk2(f[4], f[5]); w.w = pk2(f[6], f[7]); return w; }
__device__ __forceinline__ float sigm(float x) { return __builtin_amdgcn_rcpf(1.0f + __expf(-x)); }
__device__ __forceinline__ float siluf(float x) { return x * __builtin_amdgcn_rcpf(1.0f + __expf(-x)); }
__device__ __forceinline__ float softplusf(float x) { return x > 20.f ? x : log1pf(__expf(x)); }
__device__ __forceinline__ float logsigmoidf(float x) { return x < 0.f ? x - log1pf(__expf(x)) : -log1pf(__expf(-x)); }
__device__ __forceinline__ float wave_sum(float v) {
#pragma unroll
    for (int o = 1; o < 64; o <<= 1) v += __shfl_xor(v, o);
    return v;
}

#define XB_TMO      128
#define XB_XCNT(j)  (256  + 64 * (j))
#define XB_XSUB(j)  (1280 + 64 * (j))
#define XB_XGEN(j)  (2304 + 64 * (j))
#define XB_TOP      3328
#define XB_TOPGEN   3392
#define XCD_BAR_WORDS 3456
#define XB_SPIN_CAP (1u << 20)
__device__ __forceinline__ unsigned xb_ld(unsigned* p)              { return __hip_atomic_load(p, __ATOMIC_RELAXED, __HIP_MEMORY_SCOPE_AGENT); }
__device__ __forceinline__ unsigned xb_add(unsigned* p, unsigned v) { return __hip_atomic_fetch_add(p, v, __ATOMIC_RELAXED, __HIP_MEMORY_SCOPE_AGENT); }
__device__ __forceinline__ unsigned xb_xcc_id() { return (unsigned)__builtin_amdgcn_s_getreg((3 << 11) | 20) & 0xFu; }
#define XB_SPIN(cond, bar) do { unsigned _sp = 0; while (cond) { __builtin_amdgcn_s_sleep(1); \
    if ((++_sp & 255u) == 0u) { if (xb_ld(&(bar)[XB_TMO])) break; if (_sp > XB_SPIN_CAP) { atomicAdd(&(bar)[XB_TMO], 1u); break; } } } } while (0)
struct XcdBarrier { unsigned* bar; unsigned x; volatile LAS unsigned* st; };
__device__ __forceinline__ XcdBarrier xcd_barrier_post(unsigned* bar, volatile LAS unsigned* st) {
    XcdBarrier b; b.bar = bar; b.x = xb_xcc_id(); b.st = st;
    if (threadIdx.x == 0) (void)xb_add(&bar[XB_XCNT(b.x)], 1u);
    return b;
}
__device__ __forceinline__ void xcd_barrier_complete(unsigned* bar, unsigned x, unsigned& nloc, unsigned& nx) {
    const unsigned G = gridDim.x * gridDim.y * gridDim.z;
    unsigned sum, cnt, mine, sp = 0u;
    for (;;) {
        sum = 0u; cnt = 0u; mine = 0u;
#pragma unroll
        for (unsigned j = 0; j < 16; ++j) { const unsigned c = xb_ld(&bar[XB_XCNT(j)]); sum += c; cnt += (c > 0u) ? 1u : 0u; mine = (j == x) ? c : mine; }
        if (sum == G) break;
        __builtin_amdgcn_s_sleep(1);
        if ((++sp & 255u) == 0u) { if (xb_ld(&bar[XB_TMO])) break; if (sp > XB_SPIN_CAP) { atomicAdd(&bar[XB_TMO], 1u); break; } }
    }
    nloc = mine > 0u ? mine : 1u; nx = cnt > 0u ? cnt : 1u;
}
__device__ __forceinline__ void xcd_barrier(const XcdBarrier& b) {
    asm volatile("s_waitcnt vmcnt(0)" ::: "memory");
    __syncthreads();
    if (threadIdx.x == 0) {
        unsigned long long pb_ = (unsigned long long)b.bar; asm volatile("" : "+v"(pb_));
        unsigned* bar = (unsigned*)pb_;
        __builtin_amdgcn_s_waitcnt(0);
        unsigned nloc = b.st[0], nx = b.st[1];
        if (nloc == 0u) { xcd_barrier_complete(bar, b.x, nloc, nx); b.st[0] = nloc; b.st[1] = nx; }
        const unsigned old = xb_add(&bar[XB_XSUB(b.x)], 1u);
        const unsigned gen = old / nloc;
        if (old + 1u == (gen + 1u) * nloc) {
            __builtin_amdgcn_fence(__ATOMIC_RELEASE, "agent");
            asm volatile("s_waitcnt vmcnt(0)" ::: "memory");
            const unsigned og = xb_add(&bar[XB_TOP], 1u);
            const unsigned tg = og / nx;
            if (og + 1u != (tg + 1u) * nx) XB_SPIN(xb_ld(&bar[XB_TOP]) < (tg + 1u) * nx, bar);
            __builtin_amdgcn_fence(__ATOMIC_ACQUIRE, "agent");
            asm volatile("s_waitcnt vmcnt(0)" ::: "memory");
        } else {
            XB_SPIN(xb_ld(&bar[XB_TOP]) < (gen + 1u) * nx, bar);
            __builtin_amdgcn_fence(__ATOMIC_ACQUIRE, "agent");
            asm volatile("s_waitcnt vmcnt(0)" ::: "memory");
        }
    }
    __syncthreads();
}

struct Args { const float* in[25]; float* out; unsigned char* ws; int ph_lo, ph_hi; };
enum { I_X = 0, I_NORMW, I_WIN, I_SCW, I_SCB, I_DTB, I_ALOG, I_SD, I_SNW, I_MCW, I_MCB, I_WQ, I_WK, I_WV, I_WIF, I_BIF, I_MNW, I_MSKIP, I_HLB, I_HNW, I_WBS, I_WBM, I_WBH, I_WOUT, I_FNW };

__device__ __forceinline__ void transpose_item(const float* W, int ldw, int srcn0, int k0, bf16* WT, int ldt, int dstn0, int dstk0, LAS float* scr, int lane) {
#pragma unroll 8
    for (int i = 0; i < 32; ++i) { const int kk = 2 * i + (lane >> 5); scr[kk * 33 + (lane & 31)] = W[(size_t)(k0 + kk) * ldw + srcn0 + (lane & 31)]; }
    LDS_WAIT(); asm volatile("" ::: "memory");
    const int c = lane & 7;
#pragma unroll
    for (int j = 0; j < 4; ++j) { const int n = (lane >> 3) + 8 * j; const LAS float* s = scr + (8 * c) * 33 + n;
        v4u o; o.x = pk2(s[0 * 33], s[1 * 33]); o.y = pk2(s[2 * 33], s[3 * 33]); o.z = pk2(s[4 * 33], s[5 * 33]); o.w = pk2(s[6 * 33], s[7 * 33]);
        *(GAS v4u*)(WT + (size_t)(dstn0 + n) * ldt + dstk0 + k0 + 8 * c) = o; }
    LDS_WAIT(); asm volatile("" ::: "memory");
}
__device__ __forceinline__ void rms_row_to_bf16(const float* xrow, const float* w, bf16* orow, int lane) {
    const GAS f32x4* xr = (const GAS f32x4*)xrow + lane; const GAS f32x4* wr = (const GAS f32x4*)w + lane;
    f32x4 v[4]; float s = 0.f;
#pragma unroll
    for (int j = 0; j < 4; ++j) { v[j] = xr[64 * j]; s += (v[j].x * v[j].x + v[j].y * v[j].y) + (v[j].z * v[j].z + v[j].w * v[j].w); }
    const float rstd = 1.0f / sqrtf(wave_sum(s) * (1.f / D) + EPS);
    GAS v2u* o8 = (GAS v2u*)orow + lane;
#pragma unroll
    for (int j = 0; j < 4; ++j) { const f32x4 ww = wr[64 * j]; v2u o; o.x = pk2(v[j].x * rstd * ww.x, v[j].y * rstd * ww.y); o.y = pk2(v[j].z * rstd * ww.z, v[j].w * rstd * ww.w); o8[64 * j] = o; }
}
__device__ __forceinline__ void phase_norm(const float* X, const float* w, bf16* XN, int gw, int NGW, int lane) {
    const GAS f32x4* wr = (const GAS f32x4*)w + lane;
    f32x4 ww[4];
#pragma unroll
    for (int j = 0; j < 4; ++j) ww[j] = wr[64 * j];
    for (int m = gw; m < M; m += 4 * NGW) {
        f32x4 v[4][4];
#pragma unroll
        for (int u = 0; u < 4; ++u) { const int mm = (m + u * NGW < M) ? m + u * NGW : m; const GAS f32x4* xr = (const GAS f32x4*)(X + (size_t)mm * D) + lane;
#pragma unroll
            for (int j = 0; j < 4; ++j) v[u][j] = __builtin_nontemporal_load(&xr[64 * j]); }
#pragma unroll
        for (int u = 0; u < 4; ++u) { if (m + u * NGW < M) { float s0 = 0.f;
#pragma unroll
            for (int j = 0; j < 4; ++j) s0 += (v[u][j].x * v[u][j].x + v[u][j].y * v[u][j].y) + (v[u][j].z * v[u][j].z + v[u][j].w * v[u][j].w);
            const float r0 = __builtin_amdgcn_rsqf(wave_sum(s0) * (1.f / D) + EPS);
            GAS v2u* o0 = (GAS v2u*)(XN + (size_t)(m + u * NGW) * D) + lane;
#pragma unroll
            for (int j = 0; j < 4; ++j) { v2u o; o.x = pk2(v[u][j].x * r0 * ww[j].x, v[u][j].y * r0 * ww[j].y); o.y = pk2(v[u][j].z * r0 * ww[j].z, v[u][j].w * r0 * ww[j].w); o0[64 * j] = o; } } }
    }
}
__device__ __forceinline__ void transpose_item_wg(const float* W, int ldw, int srcn0, int k0, bf16* WT, int ldt, int dstn0, int dstk0, LAS unsigned char* lds, int tid) {
    const int w = tid >> 6, lane = tid & 63;
    typedef float f32x4w __attribute__((ext_vector_type(4)));
    f32x4w v_[8];
#pragma unroll
    for (int i = 0; i < 8; ++i) v_[i] = __builtin_nontemporal_load((const GAS f32x4w*)(W + (size_t)(k0 + 8 * w + i) * ldw + srcn0 + 4 * lane));
    LAS bf16* Tt = (LAS bf16*)lds;
#pragma unroll
    for (int j = 0; j < 4; ++j) { v4u o; o.x = pk2(v_[0][j], v_[1][j]); o.y = pk2(v_[2][j], v_[3][j]); o.z = pk2(v_[4][j], v_[5][j]); o.w = pk2(v_[6][j], v_[7][j]);
        *(LAS v4u*)(Tt + (4 * lane + j) * 72 + 8 * w) = o; }
    __syncthreads();
#pragma unroll
    for (int i = 0; i < 4; ++i) { const int idx = tid + NTHR * i, n = idx >> 3, ch = idx & 7;
        *(GAS v4u*)(WT + (size_t)(dstn0 + n) * ldt + dstk0 + k0 + 8 * ch) = *(const LAS v4u*)(Tt + n * 72 + 8 * ch); }
    __syncthreads();
}
__device__ __forceinline__ void phase_weights(const Args& a, unsigned char* ws, int l, LAS unsigned char* lds, int gw, int NGW, int wave, int lane, int bx = 0, int G = 1, int tid = 0) {
    LAS float* scr = (LAS float*)(lds + wave * 16384);
    const float* w_in = a.in[I_WIN] + (size_t)l * D * N_IN;
    bf16* W1 = (bf16*)(ws + WS_W1); bf16* W2 = (bf16*)(ws + WS_W2); bf16* WBR = (bf16*)(ws + WS_WBR); bf16* WOUT = (bf16*)(ws + WS_WOUT); bf16* WQKV = (bf16*)(ws + WS_WQKV); bf16* WDT = (bf16*)(ws + WS_WDT);
    constexpr int I_1 = 16 * (PJ / 32), I_2 = 16 * (3072 / 32), I_BS = 16 * 32, I_BM = 8 * 32, I_BH = 8 * 32, I_O = 16 * 32, I_QKV = 3 * 4 * 2 * 4;
    constexpr int NITEMS = I_1 + I_2 + I_BS + I_BM + I_BH + I_O + I_QKV;
    constexpr int J_1 = 16 * (PJ / 256), J_2 = 16 * (3072 / 256), J_BS = 16 * 4, J_BM = 8 * 4, J_BH = 8 * 4, J_O = 16 * 4, NJ = J_1 + J_2 + J_BS + J_BM + J_BH + J_O;
    if (G > 1) {
        for (int it = bx; it < NJ; it += G) {
            int r = it;
            const float* src; int ldw, srcn0, k0, ldt, dstn0, dstk0; bf16* dst;
            if (r < J_1) { const int nb = r % (PJ / 256), kb = r / (PJ / 256); src = w_in; ldw = N_IN; srcn0 = orig_col(nb * 256); k0 = kb * 64; dst = W1; ldt = D; dstn0 = nb * 256; dstk0 = 0; }
            else if ((r -= J_1) < J_2) { const int nb = r % 12, kb = r / 12; src = w_in; ldw = N_IN; srcn0 = O_GATE + nb * 256; k0 = kb * 64; dst = W2; ldt = D; dstn0 = nb * 256; dstk0 = 0; }
            else if ((r -= J_2) < J_BS) { const int nb = r % 4, kb = r / 4; src = a.in[I_WBS] + (size_t)l * 1024 * 1024; ldw = 1024; srcn0 = nb * 256; k0 = kb * 64; dst = WBR; ldt = 2048; dstn0 = nb * 256; dstk0 = 0; }
            else if ((r -= J_BS) < J_BM) { const int nb = r % 4, kb = r / 4; src = a.in[I_WBM] + (size_t)l * 512 * 1024; ldw = 1024; srcn0 = nb * 256; k0 = kb * 64; dst = WBR; ldt = 2048; dstn0 = nb * 256; dstk0 = 1024; }
            else if ((r -= J_BM) < J_BH) { const int nb = r % 4, kb = r / 4; src = a.in[I_WBH] + (size_t)l * 512 * 1024; ldw = 1024; srcn0 = nb * 256; k0 = kb * 64; dst = WBR; ldt = 2048; dstn0 = nb * 256; dstk0 = 1536; }
            else { r -= J_BH; const int nb = r % 4, kb = r / 4; src = a.in[I_WOUT] + (size_t)l * 1024 * 1024; ldw = 1024; srcn0 = nb * 256; k0 = kb * 64; dst = WOUT; ldt = 1024; dstn0 = nb * 256; dstk0 = 0; }
            transpose_item_wg(src, ldw, srcn0, k0, dst, ldt, dstn0, dstk0, lds, tid);
        }
    }
    for (int it = gw + (G > 1 ? NITEMS - I_QKV : 0); it < NITEMS; it += NGW) {
        int r = it;
        const float* src; int ldw, srcn0, k0, ldt, dstn0, dstk0; bf16* dst;
        if (r < I_1) { const int nb = r % (PJ / 32), kb = r / (PJ / 32); src = w_in; ldw = N_IN; srcn0 = orig_col(nb * 32); k0 = kb * 64; dst = W1; ldt = D; dstn0 = nb * 32; dstk0 = 0; }
        else if ((r -= I_1) < I_2) { const int nb = r % 96, kb = r / 96; src = w_in; ldw = N_IN; srcn0 = O_GATE + nb * 32; k0 = kb * 64; dst = W2; ldt = D; dstn0 = nb * 32; dstk0 = 0; }
        else if ((r -= I_2) < I_BS) { const int nb = r % 32, kb = r / 32; src = a.in[I_WBS] + (size_t)l * 1024 * 1024; ldw = 1024; srcn0 = nb * 32; k0 = kb * 64; dst = WBR; ldt = 2048; dstn0 = nb * 32; dstk0 = 0; }
        else if ((r -= I_BS) < I_BM) { const int nb = r % 32, kb = r / 32; src = a.in[I_WBM] + (size_t)l * 512 * 1024; ldw = 1024; srcn0 = nb * 32; k0 = kb * 64; dst = WBR; ldt = 2048; dstn0 = nb * 32; dstk0 = 1024; }
        else if ((r -= I_BM) < I_BH) { const int nb = r % 32, kb = r / 32; src = a.in[I_WBH] + (size_t)l * 512 * 1024; ldw = 1024; srcn0 = nb * 32; k0 = kb * 64; dst = WBR; ldt = 2048; dstn0 = nb * 32; dstk0 = 1536; }
        else if ((r -= I_BH) < I_O) { const int nb = r % 32, kb = r / 32; src = a.in[I_WOUT] + (size_t)l * 1024 * 1024; ldw = 1024; srcn0 = nb * 32; k0 = kb * 64; dst = WOUT; ldt = 1024; dstn0 = nb * 32; dstk0 = 0; }
        else { r -= I_O; const int nb = r % 4, kb = (r / 4) % 2, h = (r / 8) % 4, which = r / 32;
            src = (which == 0 ? a.in[I_WQ] : (which == 1 ? a.in[I_WK] : a.in[I_WV])) + ((size_t)l * 4 + h) * 128 * 128; ldw = 128; srcn0 = nb * 32; k0 = kb * 64;
            dst = WQKV + ((size_t)which * 4 + h) * 128 * 128; ldt = 128; dstn0 = nb * 32; dstk0 = 0; }
        transpose_item(src, ldw, srcn0, k0, dst, ldt, dstn0, dstk0, scr, lane);
    }
    if (gw >= NGW - 1024) {
        const int item = gw - (NGW - 1024), part = item >> 9, h = (item >> 7) & 3, d = item & 127;
        const float* wif_ = a.in[I_WIF] + (size_t)l * 1536 * 8 + (size_t)h * 384 * 8;
        typedef float f32x4w __attribute__((ext_vector_type(4)));
        typedef float f32x2w __attribute__((ext_vector_type(2)));
        float acc[8] = {0.f, 0.f, 0.f, 0.f, 0.f, 0.f, 0.f, 0.f};
#pragma unroll
        for (int p2 = 0; p2 < 2; ++p2) {
            const int pp_ = (part == 0) ? p2 : 2;
            if (part == 0 || p2 == 0) {
                const float* wr_ = (pp_ == 0 ? a.in[I_WQ] : (pp_ == 1 ? a.in[I_WK] : a.in[I_WV])) + (((size_t)l * 4 + h) * 128 + d) * 128;
                const float* wc_ = wif_ + (size_t)pp_ * 128 * 8 + (size_t)(2 * lane) * 8;
                const f32x2w x_ = *(const f32x2w*)(wr_ + 2 * lane);
                const f32x4w c00 = *(const f32x4w*)wc_, c01 = *(const f32x4w*)(wc_ + 4), c10 = *(const f32x4w*)(wc_ + 8), c11 = *(const f32x4w*)(wc_ + 12);
#pragma unroll
                for (int j = 0; j < 4; ++j) { acc[j] += x_.x * c00[j] + x_.y * c10[j]; acc[4 + j] += x_.x * c01[j] + x_.y * c11[j]; }
            }
        }
#pragma unroll
        for (int j = 0; j < 8; ++j) acc[j] = wave_sum(acc[j]);
        bf16* G = (bf16*)(ws + WS_GIF);
        if (lane < 8) { float v_ = acc[0];
#pragma unroll
            for (int j = 1; j < 8; ++j) v_ = (lane == j) ? acc[j] : v_;
            G[(size_t)lane * 1024 + part * 512 + h * 128 + d] = (bf16)f2bf(v_); G[(size_t)(8 + lane) * 1024 + part * 512 + h * 128 + d] = (bf16)0; }
    }
    for (int g2 = gw; g2 < 16 * D / 64; g2 += NGW) { const int i = g2 * 64 + lane, h = i >> 10, k = i & (D - 1); WDT[i] = (bf16)f2bf(w_in[(size_t)k * N_IN + O_DT + h]); }
}

__device__ __forceinline__ float hg_lower_bound(const float* hlb, int l, int c) {
    float mx = hlb[c];
#pragma unroll
    for (int d = 1; d < DEPTH; ++d) mx = fmaxf(mx, hlb[d * 512 + c]);
    float sum = 0.f, part = 0.f;
#pragma unroll
    for (int d = 0; d < DEPTH; ++d) { const float e = __expf(hlb[d * 512 + c] - mx); sum += e; if (d >= 1 && d <= l) part += e; }
    return part / sum;
}
typedef short s16x8 __attribute__((ext_vector_type(8)));
#define MFMA16(a_, b_, c_) __builtin_amdgcn_mfma_f32_16x16x32_bf16((a_), (b_), (c_), 0, 0, 0)
constexpr int MP = 520;
__device__ __forceinline__ void phase_c0(const Args& a, unsigned char* ws, int l, LAS unsigned char* lds, int tile, int tid) {
    bf16* PROJ = (bf16*)(ws + WS_PROJ); bf16* XNQK = (bf16*)(ws + WS_XN); const bf16* HALO = (const bf16*)(ws + WS_HALO);
    bf16* QKD = (l == 0) ? (bf16*)a.out : (bf16*)a.out + 1024; const int qk_ld = (l == 0) ? 1024 : 2048;
    const bf16* WDT = (const bf16*)(ws + WS_WDT); const bf16* WQKV = (const bf16*)(ws + WS_WQKV);
    float* DT = (float*)(ws + WS_DT); float* IFB = (float*)(ws + WS_IF); bf16* SCRV = (bf16*)(ws + WS_SCR);
    const int t0 = tile * 64;
    const int lane = tid & 63, w = tid >> 6, q = lane >> 4, r = lane & 15;
    {
        const int tw = w & 3, kh = w >> 2;
        const bf16* xrow = XNQK + (size_t)(t0 + 16 * tw + r) * D + kh * 512 + 8 * q;
        const bf16* wrow = WDT + (size_t)r * D + kh * 512 + 8 * q;
        f32x4 d = (f32x4){0.f, 0.f, 0.f, 0.f};
#pragma unroll 8
        for (int ks = 0; ks < 16; ++ks) d = MFMA16(*(const GAS s16x8*)(xrow + 32 * ks), *(const GAS s16x8*)(wrow + 32 * ks), d);
        LAS float* dtp = (LAS float*)lds;
#pragma unroll
        for (int i = 0; i < 4; ++i) dtp[(kh * 64 + 16 * tw + 4 * q + i) * 16 + r] = d[i];
        LDS_BARRIER();
        const float* dtb = a.in[I_DTB] + l * 16;
#pragma unroll
        for (int o = tid; o < 1024; o += NTHR) { const float dv_ = softplusf(dtp[o] + dtp[1024 + o] + dtb[o & 15]); DT[(size_t)t0 * 16 + o] = dv_; dtp[2048 + o] = dv_; }
        LDS_BARRIER();
        { float* sc64 = (float*)(ws + ((t0 < M / 2) ? WS_SC64A : WS_SC64B)) + (size_t)(t0 % (M / 2)) * 16;
#pragma unroll
          for (int hh = 0; hh < 2; ++hh) { const int h = 2 * w + hh; const float aneg = -__expf(a.in[I_ALOG][l * 16 + h]);
              float inc = dtp[2048 + lane * 16 + h] * aneg;
#pragma unroll
              for (int o = 1; o < 64; o <<= 1) { const float t = __shfl_up(inc, o); if (lane >= o) inc += t; }
              sc64[lane * 16 + h] = inc; } }
    }
    if (!(C0SKIP & 2)) {
        const float* cw = a.in[I_SCW] + (size_t)l * 4 * 1536; const float* cb = a.in[I_SCB] + (size_t)l * 1536;
        const bool seq_start = (t0 % T) == 0;
        const int chl = lane & 7, sq = lane >> 3;
#pragma unroll 1
        for (int blk = w; blk < 24; blk += 8) {
            const int col = blk * 64 + chl * 8;
            f32x4 wq[4][2], bq[2];
#pragma unroll
            for (int j = 0; j < 4; ++j) { wq[j][0] = *(const GAS f32x4*)(cw + j * 1536 + col); wq[j][1] = *(const GAS f32x4*)(cw + j * 1536 + col + 4); }
            bq[0] = *(const GAS f32x4*)(cb + col); bq[1] = *(const GAS f32x4*)(cb + col + 4);
#pragma unroll 1
            for (int pass = 0; pass < 2; ++pass) {
                const int strip = 8 * (1 - pass) + sq;
                v4u raw[7];
#pragma unroll
                for (int j = 0; j < 7; ++j) { const int r_ = 4 * strip - 3 + j;
                    if (r_ >= 0) raw[j] = *(const GAS v4u*)(PROJ + (size_t)(t0 + r_) * PJ + col);
                    else if (seq_start) raw[j] = (v4u){0u, 0u, 0u, 0u};
                    else raw[j] = *(const GAS v4u*)(HALO + ((size_t)(tile - 1) * 3 + (r_ + 3)) * HALO_COLS + col); }
                v4u outw[4];
#pragma unroll
                for (int wd = 0; wd < 4; ++wd) {
                    float xl[7], xh[7];
#pragma unroll
                    for (int j = 0; j < 7; ++j) { const unsigned u = raw[j][wd]; xl[j] = blo(u); xh[j] = bhi(u); }
#pragma unroll
                    for (int rr = 0; rr < 4; ++rr) { float sl = bq[wd >> 1][2 * (wd & 1)], sh = bq[wd >> 1][2 * (wd & 1) + 1];
#pragma unroll
                        for (int j = 0; j < 4; ++j) { sl += wq[j][wd >> 1][2 * (wd & 1)] * xl[rr + j]; sh += wq[j][wd >> 1][2 * (wd & 1) + 1] * xh[rr + j]; }
                        outw[rr][wd] = pk2(siluf(sl), siluf(sh)); }
                }
#pragma unroll
                for (int rr = 0; rr < 4; ++rr) *(GAS v4u*)(PROJ + (size_t)(t0 + 4 * strip + rr) * PJ + col) = outw[rr];
            }
        }
    }
    LDS_BARRIER();
    {
        LAS bf16* mxs = (LAS bf16*)lds;
        LAS bf16* mcs = (LAS bf16*)(lds + 69680);
        LAS float* gp = (LAS float*)lds;
        LAS bf16* outs = (LAS bf16*)(lds + 136240);
        constexpr int OP_ = 136;
        const float* mcw = a.in[I_MCW] + (size_t)l * 4 * 512; const float* mcb = a.in[I_MCB] + (size_t)l * 512;
        const float* bif = a.in[I_BIF] + (size_t)l * 8;
        const bool sst = (t0 % T) == 0;
        for (int idx = tid; idx < 67 * 64; idx += NTHR) { const int rr = idx >> 6, ch = idx & 63;
            v4u v = (v4u){0u, 0u, 0u, 0u};
            if (!(sst && rr < 3)) v = *(const GAS v4u*)(PROJ + (size_t)(t0 - 3 + rr) * PJ + C_MX + ch * 8);
            *(LAS v4u*)(mxs + rr * MP + ch * 8) = v; }
        LDS_BARRIER();
        {
            const int cg = tid & 63, sg = tid >> 6;
            f32x4 wq[4][2], bq[2];
#pragma unroll
            for (int j = 0; j < 4; ++j) { wq[j][0] = *(const GAS f32x4*)(mcw + j * 512 + 8 * cg); wq[j][1] = *(const GAS f32x4*)(mcw + j * 512 + 8 * cg + 4); }
            bq[0] = *(const GAS f32x4*)(mcb + 8 * cg); bq[1] = *(const GAS f32x4*)(mcb + 8 * cg + 4);
            v4u raw[11];
#pragma unroll
            for (int j = 0; j < 11; ++j) raw[j] = *(const LAS v4u*)(mxs + (8 * sg + j) * MP + 8 * cg);
            v4u outw[8];
#pragma unroll
            for (int wd = 0; wd < 4; ++wd) {
                float xl[11], xh[11];
#pragma unroll
                for (int j = 0; j < 11; ++j) { const unsigned u = raw[j][wd]; xl[j] = blo(u); xh[j] = bhi(u); }
#pragma unroll
                for (int rr = 0; rr < 8; ++rr) { float sl = bq[wd >> 1][2 * (wd & 1)], sh = bq[wd >> 1][2 * (wd & 1) + 1];
#pragma unroll
                    for (int j = 0; j < 4; ++j) { sl += wq[j][wd >> 1][2 * (wd & 1)] * xl[rr + j]; sh += wq[j][wd >> 1][2 * (wd & 1) + 1] * xh[rr + j]; }
                    outw[rr][wd] = pk2(siluf(sl), siluf(sh)); }
            }
#pragma unroll
            for (int rr = 0; rr < 8; ++rr) *(LAS v4u*)(mcs + (8 * sg + rr) * MP + 8 * cg) = outw[rr];
        }
        LDS_BARRIER();
        const int e0 = 16 * w;
        s16x8 af[2][4];
#define C0_WLOAD(st, cmb) do { const bf16* wb_ = WQKV + ((size_t)(cmb) * 128 + e0 + r) * 128 + 8 * q; \
            _Pragma("unroll") for (int ks = 0; ks < 4; ++ks) af[st][ks] = *(const GAS s16x8*)(wb_ + 32 * ks); } while (0)
        C0_WLOAD(0, 0); C0_WLOAD(1, 1);
#pragma unroll 1
        for (int c2 = 0; c2 < 12; c2 += 2) {
#pragma unroll
          for (int u = 0; u < 2; ++u) {
            const int combo = c2 + u, which = combo >> 2, h = combo & 3;
            const LAS bf16* src = (which == 2) ? (mxs + 3 * MP) : mcs;
            {
                s16x8 bfr[4][4];
#pragma unroll
                for (int tt = 0; tt < 4; ++tt)
#pragma unroll
                    for (int ks = 0; ks < 4; ++ks) bfr[tt][ks] = *(const LAS s16x8*)(src + (16 * tt + r) * MP + h * 128 + 32 * ks + 8 * q);
                SCHED_FENCE();
                f32x4 d[4];
#pragma unroll
                for (int tt = 0; tt < 4; ++tt) d[tt] = (f32x4){0.f, 0.f, 0.f, 0.f};
#pragma unroll
                for (int ks = 0; ks < 4; ++ks)
#pragma unroll
                    for (int tt = 0; tt < 4; ++tt) d[tt] = MFMA16(af[u][ks], bfr[tt][ks], d[tt]);
                SCHED_FENCE();
                if (combo + 2 < 12) C0_WLOAD(u, combo + 2);
                SCHED_FENCE();
#pragma unroll
                for (int tt = 0; tt < 4; ++tt) { v2u o; o.x = pk2(d[tt][0], d[tt][1]); o.y = pk2(d[tt][2], d[tt][3]); *(LAS v2u*)(outs + (16 * tt + r) * OP_ + e0 + 4 * q) = o; }
            }
            LDS_BARRIER();
            {
                bf16* dbase = (which < 2) ? (QKD + (size_t)t0 * qk_ld + which * 512 + h * 128) : (SCRV + (size_t)t0 * 1024 + 512 + h * 128); const int d_ld = (which < 2) ? qk_ld : 1024;
#pragma unroll
                for (int i2 = 0; i2 < 2; ++i2) { const int idx = tid + NTHR * i2, row = idx >> 4, ch = idx & 15;
                    *(GAS v4u*)(dbase + (size_t)row * d_ld + ch * 8) = *(const LAS v4u*)(outs + row * OP_ + ch * 8); } }
            LDS_BARRIER();
          }
        }
        f32x4 dg = (f32x4){0.f, 0.f, 0.f, 0.f};
        { const int tg = w & 3, kh = w >> 2; const bf16* grow = (const bf16*)(ws + WS_GIF) + (size_t)r * 1024 + kh * 512 + 8 * q;
          const LAS bf16* msrc = ((kh == 1) ? (mxs + 3 * MP) : mcs) + (16 * tg + r) * MP + 8 * q;
#pragma unroll
          for (int hb = 0; hb < 2; ++hb) { s16x8 gfr[8], mfr[8];
#pragma unroll
              for (int k8 = 0; k8 < 8; ++k8) { gfr[k8] = *(const GAS s16x8*)(grow + 32 * (8 * hb + k8)); mfr[k8] = *(const LAS s16x8*)(msrc + 32 * (8 * hb + k8)); }
              SCHED_FENCE();
#pragma unroll
              for (int k8 = 0; k8 < 8; ++k8) dg = MFMA16(gfr[k8], mfr[k8], dg);
              SCHED_FENCE(); } }
        LDS_BARRIER();
        if (q < 2) *(LAS f32x4*)(gp + ((w >> 2) * 64 + 16 * (w & 3) + r) * 8 + 4 * q) = dg;
        LDS_BARRIER();
        { const int t = tid >> 3, j = tid & 7; float sacc = bif[j];
          sacc += gp[t * 8 + j] + gp[(64 + t) * 8 + j];
          const float gv_ = (j < 4) ? sacc : logsigmoidf(sacc);
          IFB[(size_t)(t0 + t) * 8 + j] = gv_; gp[4096 + t * 8 + j] = gv_; }
        LDS_BARRIER();
        if (w < 4) {
            float* mlc = (float*)(ws + WS_MLC); float* mlp = (float*)(ws + WS_MLP);
            const float li_ = gp[4096 + lane * 8 + w]; float inc = gp[4096 + lane * 8 + 4 + w];
#pragma unroll
            for (int o = 1; o < 64; o <<= 1) { const float t = __shfl_up(inc, o); if (lane >= o) inc += t; }
            float pm = li_ - inc;
#pragma unroll
            for (int o = 1; o < 64; o <<= 1) { const float t = __shfl_up(pm, o); if (lane >= o) pm = fmaxf(pm, t); }
            mlc[(size_t)(t0 + lane) * 4 + w] = inc; mlp[(size_t)(t0 + lane) * 4 + w] = pm;
        }
        LDS_BARRIER();
    }
    {
        LAS bf16* FT = (LAS bf16*)lds;
        LAS bf16* QT = (LAS bf16*)(lds + 17408);
        LAS float* psum = (LAS float*)(lds + 34816);
        float* HGV = (float*)(ws + WS_HGV);
        constexpr int HP = 136;
        const int k = tid & 127, tq = tid >> 7;
        v4u pft[2], pqt[2];
#define C0_HGLOAD(hh) do { _Pragma("unroll") for (int i = 0; i < 2; ++i) { const int idx = tid + NTHR * i, row = idx >> 4, ch = idx & 15; \
            pft[i] = *(const GAS v4u*)(PROJ + (size_t)(t0 + row) * PJ + C_GF + (hh) * 128 + ch * 8); pqt[i] = *(const GAS v4u*)(PROJ + (size_t)(t0 + row) * PJ + C_GQ + (hh) * 128 + ch * 8); } } while (0)
        C0_HGLOAD(0);
#pragma unroll 1
        for (int h = 0; h < 4; ++h) {
#pragma unroll
            for (int i = 0; i < 2; ++i) { const int idx = tid + NTHR * i, row = idx >> 4, ch = idx & 15;
                *(LAS v4u*)(FT + row * HP + ch * 8) = pft[i]; *(LAS v4u*)(QT + row * HP + ch * 8) = pqt[i]; }
            if (h + 1 < 4) C0_HGLOAD(h + 1);
            LDS_BARRIER();
            const float lb = hg_lower_bound(a.in[I_HLB], l, h * 128 + k), omlb = 1.f - lb;
            float cum[16], kk[16], qq[16]; float run = 0.f;
#pragma unroll
            for (int j = 0; j < 16; ++j) { const int t = 16 * tq + j; const float sg = sigm(bf2f(FT[t * HP + k])); const float f = lb + omlb * sg; run += __logf(f); cum[j] = run; kk[j] = omlb * (1.f - sg); qq[j] = siluf(bf2f(QT[t * HP + k])); }
            psum[tq * 128 + k] = run;
            LDS_BARRIER();
            { const float p0 = psum[k], p1 = psum[128 + k], p2 = psum[256 + k], p3 = psum[384 + k];
              const float cmid = p0 + p1, cend = cmid + p2 + p3;
              const float off = (tq == 0) ? 0.f : (tq == 1 ? p0 : (tq == 2 ? cmid : cmid + p2));
              if (tq == 0) { float* hv = HGV + ((size_t)tile * 4 + h) * 384; hv[k] = __expf(cmid); hv[128 + k] = __expf(cend - cmid); hv[256 + k] = __expf(cend); }
#pragma unroll
              for (int j = 0; j < 16; ++j) { const float cj = off + cum[j]; const float em = __expf(fminf(fmaxf(cj - cmid, -80.f), 80.f)), rem = __builtin_amdgcn_rcpf(em); const int t = 16 * tq + j;
                  QT[t * HP + k] = (bf16)f2bf(qq[j] * em); FT[t * HP + k] = (bf16)f2bf(kk[j] * rem); } }
            LDS_BARRIER();
#pragma unroll
            for (int i = 0; i < 2; ++i) { const int idx = tid + NTHR * i, row = idx >> 4, ch = idx & 15;
                *(GAS v4u*)(PROJ + (size_t)(t0 + row) * PJ + C_GF + h * 128 + ch * 8) = *(const LAS v4u*)(FT + row * HP + ch * 8);
                *(GAS v4u*)(PROJ + (size_t)(t0 + row) * PJ + C_GQ + h * 128 + ch * 8) = *(const LAS v4u*)(QT + row * HP + ch * 8); }
            LDS_BARRIER();
        }
    }
}


__device__ __forceinline__ void scan_ssd_naive(const Args& a, unsigned char* ws, int l, LAS unsigned char* lds, int b, int h, int tid) {
    bf16* PROJ = (bf16*)(ws + WS_PROJ); const float* DT = (const float*)(ws + WS_DT);
    LAS float* xs = (LAS float*)lds;
    LAS float* Bs = xs + 64 * 64;
    LAS float* Cs = Bs + 64 * 128;
    LAS float* ys = Cs + 64 * 128;
    LAS float* dts = ys + 64 * 64;
    const int p = tid >> 3, nq = tid & 7, n0 = nq * 16, g = h >> 3;
    const float aneg = -__expf(a.in[I_ALOG][l * 16 + h]), Dh = a.in[I_SD][l * 16 + h];
    float hs[16];
#pragma unroll
    for (int j = 0; j < 16; ++j) hs[j] = 0.f;
    for (int blk = 0; blk < T / 64; ++blk) {
        const size_t t0 = (size_t)b * T + blk * 64;
        for (int idx = tid; idx < 64 * 40; idx += NTHR) { const int r = idx / 40, ch = idx % 40;
            int col; LAS float* dst;
            if (ch < 8) { col = C_SX + h * 64 + ch * 8; dst = xs + r * 64 + ch * 8; }
            else if (ch < 24) { col = C_SB + g * 128 + (ch - 8) * 8; dst = Bs + r * 128 + (ch - 8) * 8; }
            else { col = C_SC + g * 128 + (ch - 24) * 8; dst = Cs + r * 128 + (ch - 24) * 8; }
            float f[8]; unpack8(*(const GAS v4u*)(PROJ + (t0 + r) * PJ + col), f);
#pragma unroll
            for (int e = 0; e < 8; ++e) dst[e] = f[e]; }
        if (tid < 64) dts[tid] = DT[(t0 + tid) * 16 + h];
        __syncthreads();
        for (int tt = 0; tt < 64; ++tt) {
            const float dt = dts[tt], dA = __expf(dt * aneg), xv = xs[tt * 64 + p], dx = dt * xv;
            float y = 0.f;
#pragma unroll
            for (int j = 0; j < 16; ++j) { hs[j] = dA * hs[j] + dx * Bs[tt * 128 + n0 + j]; y += Cs[tt * 128 + n0 + j] * hs[j]; }
            y += __shfl_xor(y, 1); y += __shfl_xor(y, 2); y += __shfl_xor(y, 4);
            if (nq == 0) ys[tt * 64 + p] = y + Dh * xv;
        }
        __syncthreads();
        { const int r = tid >> 3, c8 = (tid & 7) * 8; float o[8];
#pragma unroll
          for (int e = 0; e < 8; ++e) o[e] = ys[r * 64 + c8 + e];
          *(GAS v4u*)(PROJ + (t0 + r) * PJ + C_SX + h * 64 + c8) = pack8(o); }
        __syncthreads();
    }
}
__device__ __forceinline__ void scan_ml_naive(const Args& a, unsigned char* ws, int l, LAS unsigned char* lds, int b, int h, int tid) {
    const bf16* PROJ = (const bf16*)(ws + WS_PROJ); const bf16* QK = (const bf16*)(ws + WS_XN); bf16* SCR = (bf16*)(ws + WS_SCR);
    const float* IFB = (const float*)(ws + WS_IF); const bf16* WQKV = (const bf16*)(ws + WS_WQKV);
    LAS float* qs = (LAS float*)lds;
    LAS float* ks = qs + 64 * 128;
    LAS float* ms = ks + 64 * 128;
    LAS float* hs = ms + 64 * 128;
    LAS float* is = hs + 64 * 128;
    LAS float* fs = is + 64;
    const int dv = tid >> 2, eq = tid & 3, e0 = eq * 32;
    float wv[32];
    { const GAS v4u* wr = (const GAS v4u*)(WQKV + ((size_t)(2 * 4 + h) * 128 + dv) * 128 + e0);
#pragma unroll
      for (int c = 0; c < 4; ++c) { float f[8]; unpack8(wr[c], f);
#pragma unroll
          for (int e = 0; e < 8; ++e) wv[c * 8 + e] = f[e]; } }
    float Cst[32], nst[32];
#pragma unroll
    for (int j = 0; j < 32; ++j) { Cst[j] = 0.f; nst[j] = 0.f; }
    const float qscale = 0.08838834764831845f;
    for (int blk = 0; blk < T / 64; ++blk) {
        const size_t t0 = (size_t)b * T + blk * 64;
        for (int idx = tid; idx < 64 * 48; idx += NTHR) { const int r = idx / 48, ch = idx % 48;
            const bf16* src; LAS float* dst;
            if (ch < 16) { src = QK + (t0 + r) * 1024 + h * 128 + ch * 8; dst = qs + r * 128 + ch * 8; }
            else if (ch < 32) { src = QK + (t0 + r) * 1024 + 512 + h * 128 + (ch - 16) * 8; dst = ks + r * 128 + (ch - 16) * 8; }
            else { src = PROJ + (t0 + r) * PJ + C_MX + h * 128 + (ch - 32) * 8; dst = ms + r * 128 + (ch - 32) * 8; }
            float f[8]; unpack8(*(const GAS v4u*)src, f);
#pragma unroll
            for (int e = 0; e < 8; ++e) dst[e] = f[e]; }
        if (tid < 64) { is[tid] = IFB[(t0 + tid) * 8 + h]; fs[tid] = IFB[(t0 + tid) * 8 + 4 + h]; }
        __syncthreads();
        for (int tt = 0; tt < 64; ++tt) {
            float v = 0.f;
#pragma unroll
            for (int j = 0; j < 32; ++j) v += ms[tt * 128 + e0 + j] * wv[j];
            v += __shfl_xor(v, 1); v += __shfl_xor(v, 2);
            const float f = __expf(fs[tt]), ig = __expf(is[tt]), iv = ig * v;
            float num = 0.f, den = 0.f;
#pragma unroll
            for (int j = 0; j < 32; ++j) { const float kk = ks[tt * 128 + e0 + j], qq = qs[tt * 128 + e0 + j] * qscale;
                Cst[j] = f * Cst[j] + iv * kk; nst[j] = f * nst[j] + ig * kk; num += Cst[j] * qq; den += nst[j] * qq; }
            num += __shfl_xor(num, 1); num += __shfl_xor(num, 2); den += __shfl_xor(den, 1); den += __shfl_xor(den, 2);
            if (eq == 0) hs[tt * 128 + dv] = num / fmaxf(fabsf(den), 1.0f);
        }
        __syncthreads();
        for (int idx = tid; idx < 64 * 16; idx += NTHR) { const int r = idx >> 4, c8 = (idx & 15) * 8; float o[8];
#pragma unroll
            for (int e = 0; e < 8; ++e) o[e] = hs[r * 128 + c8 + e];
            *(GAS v4u*)(SCR + (t0 + r) * 1024 + h * 128 + c8) = pack8(o); }
        __syncthreads();
    }
}
__device__ __forceinline__ void scan_hg_naive(const Args& a, unsigned char* ws, int l, LAS unsigned char* lds, int b, int h, int tid) {
    const bf16* PROJ = (const bf16*)(ws + WS_PROJ); bf16* SCR = (bf16*)(ws + WS_SCR);
    LAS float* fs = (LAS float*)lds;
    LAS float* ks = fs + 32 * 128;
    LAS float* qs = ks + 32 * 128;
    LAS float* vs = qs + 32 * 128;
    LAS float* os = vs + 32 * 128;
    const int dv = tid >> 2, kq = tid & 3, k0 = kq * 32;
    float S[32];
#pragma unroll
    for (int j = 0; j < 32; ++j) S[j] = 0.f;
    const float* hlb = a.in[I_HLB];
    for (int blk = 0; blk < T / 32; ++blk) {
        const size_t t0 = (size_t)b * T + blk * 32;
        for (int idx = tid; idx < 32 * 16; idx += NTHR) { const int r = idx >> 4, c8 = (idx & 15) * 8; const int c = h * 128 + c8;
            float gq[8], gf[8], gi[8];
            unpack8(*(const GAS v4u*)(PROJ + (t0 + r) * PJ + C_GQ + c), gq); unpack8(*(const GAS v4u*)(PROJ + (t0 + r) * PJ + C_GF + c), gf); unpack8(*(const GAS v4u*)(PROJ + (t0 + r) * PJ + C_GI + c), gi);
#pragma unroll
            for (int e = 0; e < 8; ++e) { const float lb = hg_lower_bound(hlb, l, c + e); const float sg = sigm(gf[e]);
                fs[r * 128 + c8 + e] = lb + (1.f - lb) * sg; ks[r * 128 + c8 + e] = (1.f - lb) * (1.f - sg); qs[r * 128 + c8 + e] = siluf(gq[e]); vs[r * 128 + c8 + e] = gi[e]; } }
        __syncthreads();
        for (int tt = 0; tt < 32; ++tt) {
            const float v = vs[tt * 128 + dv]; float o = 0.f;
#pragma unroll
            for (int j = 0; j < 32; ++j) { S[j] = fs[tt * 128 + k0 + j] * S[j] + ks[tt * 128 + k0 + j] * v; o += S[j] * qs[tt * 128 + k0 + j]; }
            o += __shfl_xor(o, 1); o += __shfl_xor(o, 2);
            if (kq == 0) os[tt * 128 + dv] = o;
        }
        __syncthreads();
        { const int r = tid >> 4, c8 = (tid & 15) * 8; float o[8];
#pragma unroll
          for (int e = 0; e < 8; ++e) o[e] = os[r * 128 + c8 + e];
          *(GAS v4u*)(SCR + (t0 + r) * 1024 + 512 + h * 128 + c8) = pack8(o); }
        __syncthreads();
    }
}

constexpr int LP = 136;
__device__ __forceinline__ s16x8 ldfrag(const LAS bf16* base, int row0, int k0, int lane) {
    return *(const LAS s16x8*)(base + (row0 + (lane & 15)) * LP + k0 + (lane >> 4) * 8);
}
__device__ __forceinline__ unsigned short bfelem(const v4u v, int j) { const unsigned wd = v[j >> 1]; return (unsigned short)((j & 1) ? (wd >> 16) : (wd & 0xffffu)); }

constexpr int LQ = 72;
__device__ __forceinline__ s16x8 ldfrag72(const LAS bf16* base, int row0, int k0, int lane);
typedef short s16x4v __attribute__((ext_vector_type(4)));
__device__ __forceinline__ s16x8 ldfrag_tr(const LAS bf16* Tt, int pitch, int k0, int col0, int lane) {
    const LAS bf16* a0 = Tt + (k0 + 8 * (lane >> 4) + ((lane & 15) >> 2)) * pitch + col0 + 4 * (lane & 3);
    const s16x4v lo = __builtin_amdgcn_ds_read_tr16_b64_v4i16((LAS s16x4v*)a0), hi = __builtin_amdgcn_ds_read_tr16_b64_v4i16((LAS s16x4v*)(a0 + 4 * pitch));
    return (s16x8){lo.x, lo.y, lo.z, lo.w, hi.x, hi.y, hi.z, hi.w};
}
constexpr int XP = 40;
__device__ __forceinline__ void dma16(const void* g, unsigned ldsaddr) {
    asm volatile("s_mov_b32 m0, %0\n\ts_nop 0\n\tglobal_load_lds_dwordx4 %1, off" :: "s"(ldsaddr), "v"((const GAS unsigned*)g) : "memory", "m0");
}
__device__ __forceinline__ int st_off(int r_, int c_, int ncg) { const int ob = (r_ & 15) * 64 + (c_ & 31) * 2; return ((r_ >> 4) * ncg + (c_ >> 5)) * 1024 + (ob ^ (((ob >> 9) & 1) << 5)); }
__device__ __forceinline__ s16x8 ldfragS(const LAS unsigned char* tile, int rt, int ks, int ncg, int lane) {
    const int ob = (lane & 15) * 64 + (lane >> 4) * 16; return *(const LAS s16x8*)(tile + (rt * ncg + ks) * 1024 + (ob ^ (((ob >> 9) & 1) << 5)));
}
__device__ __forceinline__ s16x8 ldfrag_trS(const LAS unsigned char* tile, int k0, int col0, int ncg, int lane) {
    const int r0 = k0 + 8 * (lane >> 4) + ((lane & 15) >> 2), c_ = col0 + 4 * (lane & 3);
    const s16x4v lo = __builtin_amdgcn_ds_read_tr16_b64_v4i16((LAS s16x4v*)(tile + st_off(r0, c_, ncg))), hi = __builtin_amdgcn_ds_read_tr16_b64_v4i16((LAS s16x4v*)(tile + st_off(r0 + 4, c_, ncg)));
    return (s16x8){lo.x, lo.y, lo.z, lo.w, hi.x, hi.y, hi.z, hi.w};
}
__device__ __forceinline__ void scan_ssd(const Args& a, unsigned char* ws, int l, LAS unsigned char* lds, int b, int h, int ph, int tid_in) {
    int tid = tid_in; asm volatile("" : "+v"(tid));
    bf16* PROJ = (bf16*)(ws + WS_PROJ); const float* DT = (const float*)(ws + WS_DT);
#define SSD_BM(X) (lds + (X) * 16384)
#define SSD_CM(X) (lds + 49152 + (X) * 16384)
#define SSD_X(X)  (lds + 98304 + (X) * 4096)
#define SSD_XS(X) ((LAS bf16*)(lds + 110592 + (X) * 5120))
#define SSD_SS(X) ((LAS bf16*)(lds + 120832 + (X) * 9216))
    LAS bf16* ST = (LAS bf16*)(lds + 139264);
#define SSD_CUM(X) ((LAS float*)(lds + 147968 + (X) * 256))
    LAS float* dts = (LAS float*)(lds + 148480);
    LAS float* wtab = (LAS float*)(lds + 148736);
    const int lane = tid & 63, w = __builtin_amdgcn_readfirstlane(tid >> 6), q = lane >> 4, r = lane & 15, g = h >> 3;
    const bool prod = w < 4; const int j4 = w & 3, gt = tid & 255;
    const float Dh = a.in[I_SD][l * 16 + h];
    const int colx = C_SX + h * 64 + ph * 32, colB = C_SB + g * 128, colC = C_SC + g * 128;
    f32x4 st[2][2];
#pragma unroll
    for (int kt = 0; kt < 2; ++kt) { st[kt][0] = (f32x4){0.f, 0.f, 0.f, 0.f}; st[kt][1] = (f32x4){0.f, 0.f, 0.f, 0.f}; }
    for (int i = tid; i < 32 * LP / 2; i += NTHR) ((LAS unsigned*)ST)[i] = 0u;
    float fd = 0.f, fc = 0.f, sclv = 0.f;
    const float* SC64 = (const float*)(ws + ((b < 2) ? WS_SC64A : WS_SC64B)) + (size_t)(b & 1) * T * 16;
    const int vrow = gt >> 2, vch = gt & 3;
#define SSD_LOAD(cc) do { const size_t t0_ = (size_t)b * T + (size_t)(cc) * 64; \
        fd = DT[(t0_ + lane) * 16 + h]; fc = SC64[((size_t)(cc) * 64 + lane) * 16 + h]; } while (0)
    const int dma_rr = lane >> 2, dma_cc = ((lane & 3) ^ ((lane >> 5) << 1)) * 8;
#define SSD_DMA(cc, B3) do { const bf16* g_ = PROJ + ((size_t)b * T + (size_t)(cc) * 64 + 16 * j4 + dma_rr) * PJ + dma_cc; \
        _Pragma("unroll") for (int cg = 0; cg < 4; ++cg) { \
            dma16(g_ + colB + 32 * cg, (unsigned)(size_t)(SSD_BM(B3) + (j4 * 4 + cg) * 1024)); \
            dma16(g_ + colC + 32 * cg, (unsigned)(size_t)(SSD_CM(B3) + (j4 * 4 + cg) * 1024)); } \
        dma16(g_ + colx, (unsigned)(size_t)(SSD_X(B3) + j4 * 1024)); } while (0)
    unsigned ob[2][2] = {{0u, 0u}, {0u, 0u}};
#define SSD_STORE(cc) do { bf16* op_ = PROJ + ((size_t)b * T + (size_t)(cc) * 64 + 16 * j4 + r) * PJ + colx + 4 * q; \
        _Pragma("unroll") for (int pt = 0; pt < 2; ++pt) { v2u o_; o_.x = ob[pt][0]; o_.y = ob[pt][1]; *(GAS v2u*)(op_ + 16 * pt) = o_; } } while (0)
    if (prod) { SSD_DMA(0, 0); SSD_LOAD(0); }
    LDS_BARRIER();
    int i3 = 2;
    s16x8 xf[2][2];
#pragma unroll
    for (int pt = 0; pt < 2; ++pt) { xf[pt][0] = (s16x8){0, 0, 0, 0, 0, 0, 0, 0}; xf[pt][1] = (s16x8){0, 0, 0, 0, 0, 0, 0, 0}; }
#pragma unroll 1
    for (int c = -1; c < T / 64; ++c) {
        const int n = c + 1, bb = n & 1, cb = c & 1, n3 = (i3 == 2) ? 0 : i3 + 1, d3 = (n3 == 2) ? 0 : n3 + 1;
        if (prod) {
            if (n < T / 64) {
                VM_WAIT();
                const float ce = __int_as_float(__builtin_amdgcn_readlane(__float_as_int(fc), 63));
                sclv = fd * __expf(ce - fc);
                if (w == 0) { SSD_CUM(bb)[lane] = fc; dts[lane] = fd; }
                else { const float cref = __int_as_float(__builtin_amdgcn_readlane(__float_as_int(fc), 16 * j4 - 1)); wtab[j4 * 64 + lane] = fd * __expf(fminf(cref - fc, 0.f)); }
                if (n + 1 < T / 64) SSD_DMA(n + 1, d3);
                SSD_LOAD((n + 1 < T / 64) ? n + 1 : n);
            }
        } else if (c >= 0) {
            s16x8 cf[4], sf[2][4], sa[2];
#pragma unroll
            for (int ks = 0; ks < 2; ++ks) { sa[ks] = ldfrag72(SSD_SS(cb), 16 * j4, 32 * ks, lane); xf[0][ks] = ldfrag_trS(SSD_X(i3), 32 * ks, 0, 1, lane); xf[1][ks] = ldfrag_trS(SSD_X(i3), 32 * ks, 16, 1, lane); }
#pragma unroll
            for (int ks = 0; ks < 4; ++ks) { cf[ks] = ldfragS(SSD_CM(i3), j4, ks, 4, lane); sf[0][ks] = ldfrag(ST, 0, 32 * ks, lane); sf[1][ks] = ldfrag(ST, 16, 32 * ks, lane); }
            const float cl1 = SSD_CUM(cb)[16 * j4 + r];
            v2u xr[2];
#pragma unroll
            for (int pt = 0; pt < 2; ++pt) xr[pt] = *(const LAS v2u*)(SSD_X(i3) + st_off(16 * j4 + r, 16 * pt + 4 * q, 1));
            SCHED_FENCE();
            f32x4 d3[2], d2[2];
#pragma unroll
            for (int pt = 0; pt < 2; ++pt) { d3[pt] = (f32x4){0.f, 0.f, 0.f, 0.f}; d2[pt] = (f32x4){0.f, 0.f, 0.f, 0.f}; }
#pragma unroll
            for (int ks = 0; ks < 2; ++ks) { d2[0] = MFMA16(xf[0][ks], sa[ks], d2[0]); d2[1] = MFMA16(xf[1][ks], sa[ks], d2[1]); }
#pragma unroll
            for (int ks = 0; ks < 4; ++ks) { d3[0] = MFMA16(sf[0][ks], cf[ks], d3[0]); d3[1] = MFMA16(sf[1][ks], cf[ks], d3[1]); }
            SCHED_FENCE();
            if (c > 0) SSD_STORE(c - 1);
            const float el = __expf(cl1);
#pragma unroll
            for (int pt = 0; pt < 2; ++pt) { float y4[4]; const float x4[4] = {blo(xr[pt].x), bhi(xr[pt].x), blo(xr[pt].y), bhi(xr[pt].y)};
#pragma unroll
                for (int i = 0; i < 4; ++i) y4[i] = d2[pt][i] + el * d3[pt][i] + Dh * x4[i];
                ob[pt][0] = pk2(y4[0], y4[1]); ob[pt][1] = pk2(y4[2], y4[3]); }
        }
        LDS_BARRIER();
        if (prod) {
            if (n < T / 64) {
                int lrow = 16 * j4 + r; asm volatile("" : "+v"(lrow));
                const LAS float* cum = SSD_CUM(bb);
                const LAS float* wt = wtab + j4 * 64;
                s16x8 cf[4], fa[2][4];
                const v4u xraw = *(const LAS v4u*)(SSD_X(n3) + st_off(vrow, vch * 8, 1));
#pragma unroll
                for (int ks = 0; ks < 4; ++ks) cf[ks] = ldfragS(SSD_CM(n3), j4, ks, 4, lane);
#pragma unroll
                for (int si = 0; si < 2; ++si)
#pragma unroll
                    for (int ks = 0; ks < 4; ++ks) fa[si][ks] = ldfragS(SSD_BM(n3), si, ks, 4, lane);
                const float cl = cum[lrow], cref = cum[(j4 > 0) ? 16 * j4 - 1 : 0];
                const f32x4 cs = *(const LAS f32x4*)(cum + 16 * j4 + 4 * q), ds = *(const LAS f32x4*)(dts + 16 * j4 + 4 * q);
                f32x4 wt4[3];
#pragma unroll
                for (int si = 0; si < 3; ++si) wt4[si] = *(const LAS f32x4*)(wt + 16 * si + 4 * q);
                SCHED_FENCE();
                {
                    const float sv = __shfl(sclv, 16 * j4 + (lane >> 2)); float xs_[8]; unpack8(xraw, xs_);
#pragma unroll
                    for (int jj = 0; jj < 8; ++jj) xs_[jj] *= sv;
                    *(LAS v4u*)(SSD_XS(bb) + vrow * XP + vch * 8) = pack8(xs_); }
                f32x4 d[4];
#pragma unroll
                for (int si = 0; si < 4; ++si) d[si] = (f32x4){0.f, 0.f, 0.f, 0.f};
#pragma unroll
                for (int ks = 0; ks < 4; ++ks)
#pragma unroll
                    for (int si = 0; si < 2; ++si) d[si] = MFMA16(fa[si][ks], cf[ks], d[si]);
                if (j4 >= 2) {
                    s16x8 fb[2][4];
#pragma unroll
                    for (int si = 0; si < 2; ++si)
#pragma unroll
                        for (int ks = 0; ks < 4; ++ks) fb[si][ks] = ldfragS(SSD_BM(n3), 2 + si, ks, 4, lane);
                    SCHED_FENCE();
#pragma unroll
                    for (int ks = 0; ks < 4; ++ks)
#pragma unroll
                        for (int si = 0; si < 2; ++si) d[2 + si] = MFMA16(fb[si][ks], cf[ks], d[2 + si]);
                }
                const float rowfac = __expf(fminf(cl - cref, 0.f));
                float dg[4];
#pragma unroll
                for (int i = 0; i < 4; ++i) dg[i] = (16 * j4 + 4 * q + i <= lrow) ? __expf(fminf(cl - cs[i], 0.f)) * ds[i] : 0.f;
                SCHED_FENCE();
#pragma unroll
                for (int si = 0; si < 4; ++si) { const int s0 = 16 * si + 4 * q; float v[4];
#pragma unroll
                    for (int i = 0; i < 4; ++i) { const float fac = (si < j4) ? rowfac * wt4[si < 3 ? si : 2][i] : ((si == j4) ? dg[i] : 0.f); v[i] = (si <= j4) ? d[si][i] * fac : 0.f; }
                    v2u o; o.x = pk2(v[0], v[1]); o.y = pk2(v[2], v[3]); *(LAS v2u*)(SSD_SS(bb) + lrow * LQ + s0) = o; }
            }
        } else if (c >= 0) {
            s16x8 ba[2][2], xsf[2][2];
#pragma unroll
            for (int kt = 0; kt < 2; ++kt)
#pragma unroll
                for (int ks = 0; ks < 2; ++ks) ba[kt][ks] = ldfrag_trS(SSD_BM(i3), 32 * ks, 16 * (2 * j4 + kt), 4, lane);
#pragma unroll
            for (int pt = 0; pt < 2; ++pt)
#pragma unroll
                for (int ks = 0; ks < 2; ++ks) xsf[pt][ks] = ldfrag_tr(SSD_XS(cb), XP, 32 * ks, 16 * pt, lane);
            const float dec = __expf(SSD_CUM(cb)[63]);
#pragma unroll
            for (int kt = 0; kt < 2; ++kt) { st[kt][0] = st[kt][0] * dec; st[kt][1] = st[kt][1] * dec; }
            SCHED_FENCE();
#pragma unroll
            for (int ks = 0; ks < 2; ++ks)
#pragma unroll
                for (int kt = 0; kt < 2; ++kt) { st[kt][0] = MFMA16(ba[kt][ks], xsf[0][ks], st[kt][0]); st[kt][1] = MFMA16(ba[kt][ks], xsf[1][ks], st[kt][1]); }
            SCHED_FENCE();
#pragma unroll
            for (int kt = 0; kt < 2; ++kt)
#pragma unroll
                for (int pt = 0; pt < 2; ++pt) { v2u o; o.x = pk2(st[kt][pt][0], st[kt][pt][1]); o.y = pk2(st[kt][pt][2], st[kt][pt][3]);
                    *(LAS v2u*)(ST + (16 * pt + r) * LP + 16 * (2 * j4 + kt) + 4 * q) = o; }
        }
        LDS_BARRIER();
        i3 = n3;
    }
    if (!prod) SSD_STORE(T / 64 - 1);
#undef SSD_STORE
#undef SSD_LOAD
#undef SSD_DMA
#undef SSD_CM
#undef SSD_BM
#undef SSD_XS
#undef SSD_SS
#undef SSD_X
#undef SSD_CUM
}
__device__ __forceinline__ s16x8 ldfrag72(const LAS bf16* base, int row0, int k0, int lane);
__device__ __forceinline__ void scan_ml(const Args& a, unsigned char* ws, int l, LAS unsigned char* lds, int b, int h, int dq, int tid_in) {
    int tid = tid_in; asm volatile("" : "+v"(tid));
    const bf16* QK = (l == 0) ? (const bf16*)a.out : (const bf16*)a.out + 1024; const int qk_ld = (l == 0) ? 1024 : 2048;
    bf16* SCR = (bf16*)(ws + WS_SCR); const float* IFB = (const float*)(ws + WS_IF);
    const float* MLC = (const float*)(ws + WS_MLC); const float* MLP = (const float*)(ws + WS_MLP);
    constexpr int LQ_ = 72, VSP = 56;
#define ML_Q(X)  (lds + (X) * 16384)
#define ML_K(X)  (lds + 49152 + (X) * 16384)
#define ML_V(X)  (lds + 98304 + (X) * 4096)
#define ML_VS(X) ((LAS bf16*)(lds + 110592 + (X) * 7168))
#define ML_P(X)  ((LAS bf16*)(lds + 124928 + (X) * 9216))
    LAS bf16* CS = (LAS bf16*)(lds + 143360);
    LAS bf16* NS = (LAS bf16*)(lds + 152064);
#define ML_VEC(X) ((LAS float*)(lds + 156416 + (X) * 1024))
    LAS float* rowfv = (LAS float*)(lds + 158464);
    LAS float* colfv = rowfv + 64;
    LAS float* denv = (LAS float*)(lds + 158976);
    const int lane = tid & 63, w = __builtin_amdgcn_readfirstlane(tid >> 6), q = lane >> 4, r = lane & 15;
    const bool prod = w < 4; const int j4 = w & 3, gt = tid & 255;
    const float qscale = 0.08838834764831845f;
    f32x4 cst[2][2], nreg[2];
#pragma unroll
    for (int et = 0; et < 2; ++et) { cst[et][0] = (f32x4){0.f, 0.f, 0.f, 0.f}; cst[et][1] = (f32x4){0.f, 0.f, 0.f, 0.f}; nreg[et] = (f32x4){0.f, 0.f, 0.f, 0.f}; }
    float m_s = 0.f;
    for (int i = tid; i < (32 + 16) * LP / 2; i += NTHR) ((LAS unsigned*)CS)[i] = 0u;
    for (int i = tid; i < 2 * 64 * VSP / 2; i += NTHR) ((LAS unsigned*)ML_VS(0))[i] = 0u;
    float pli = 0.f, pc = 0.f, pp = 0.f;
    const int vrow = gt >> 2, vch = gt & 3;
#define ML_LOAD(cc) do { const size_t t0_ = (size_t)b * T + (size_t)(cc) * 64; \
        if (w == 0) { pli = IFB[(t0_ + lane) * 8 + h]; pc = MLC[(t0_ + lane) * 4 + h]; pp = MLP[(t0_ + lane) * 4 + h]; } } while (0)
    const int dma_rr = lane >> 2, dma_cc = ((lane & 3) ^ ((lane >> 5) << 1)) * 8;
#define ML_DMA(cc, B3) do { const size_t row_ = (size_t)b * T + (size_t)(cc) * 64 + 16 * j4 + dma_rr; const bf16* g_ = QK + row_ * qk_ld + h * 128 + dma_cc; \
        _Pragma("unroll") for (int cg = 0; cg < 4; ++cg) { \
            dma16(g_ + 32 * cg, (unsigned)(size_t)(ML_Q(B3) + (j4 * 4 + cg) * 1024)); \
            dma16(g_ + 512 + 32 * cg, (unsigned)(size_t)(ML_K(B3) + (j4 * 4 + cg) * 1024)); } \
        dma16(SCR + row_ * 1024 + 512 + h * 128 + dq * 32 + dma_cc, (unsigned)(size_t)(ML_V(B3) + j4 * 1024)); } while (0)
    unsigned ob[4] = {0u, 0u, 0u, 0u};
#define ML_STORE(cc) do { bf16* op_ = SCR + ((size_t)b * T + (size_t)(cc) * 64 + 16 * j4 + r) * 1024 + h * 128 + dq * 32 + 4 * q; \
        _Pragma("unroll") for (int dvt = 0; dvt < 2; ++dvt) { v2u o_; o_.x = ob[2 * dvt]; o_.y = ob[2 * dvt + 1]; *(GAS v2u*)(op_ + 16 * dvt) = o_; } } while (0)
    if (prod) { ML_DMA(0, 0); ML_LOAD(0); }
    LDS_BARRIER();
    int i3 = 2;
    f32x4 d2[2], d3[2];
    d2[0] = d2[1] = d3[0] = d3[1] = (f32x4){0.f, 0.f, 0.f, 0.f};
#pragma unroll 1
    for (int c = -1; c < T / 64; ++c) {
        const int n = c + 1, bb = n & 1, cb = c & 1, n3 = (i3 == 2) ? 0 : i3 + 1, nn3 = (n3 == 2) ? 0 : n3 + 1;
        if (prod) {
            if (n < T / 64) {
                VM_WAIT();
                if (w == 0) {
                    const float g = __int_as_float(__builtin_amdgcn_readlane(__float_as_int(pp), 63)), cend = __int_as_float(__builtin_amdgcn_readlane(__float_as_int(pc), 63));
                    const float mloc = cend + g;
                    const float mt_ = fmaxf(pc + m_s, pc + pp);
                    const float m_new = fmaxf(cend + m_s, mloc);
                    LAS float* vb_ = ML_VEC(bb);
                    vb_[lane] = __expf(pc + m_s - mt_); vb_[64 + lane] = __expf(-mt_);
                    rowfv[lane] = qscale * __expf(fminf(pc + g - mt_, 80.f)); colfv[lane] = __expf(pli - pc - g);
                    if (lane == 0) { vb_[192] = __expf(cend + m_s - m_new); vb_[193] = __expf(mloc - m_new); }
                    m_s = m_new;
                }
                if (n + 1 < T / 64) ML_DMA(n + 1, nn3);
                ML_LOAD((n + 1 < T / 64) ? n + 1 : n);
            }
        } else if (c >= 0) {
            const LAS float* vc_ = ML_VEC(cb);
            s16x8 qf[4], cfr[2][4], nsf[4], pf[2], v0[2], v1[2];
#pragma unroll
            for (int ks = 0; ks < 2; ++ks) { pf[ks] = ldfrag72(ML_P(cb), 16 * j4, 32 * ks, lane); v0[ks] = ldfrag_trS(ML_V(i3), 32 * ks, 0, 1, lane); v1[ks] = ldfrag_trS(ML_V(i3), 32 * ks, 16, 1, lane); }
#pragma unroll
            for (int ks = 0; ks < 4; ++ks) { qf[ks] = ldfragS(ML_Q(i3), j4, ks, 4, lane); cfr[0][ks] = ldfrag(CS, 0, 32 * ks, lane); cfr[1][ks] = ldfrag(CS, 16, 32 * ks, lane); nsf[ks] = ldfrag(NS, 0, 32 * ks, lane); }
            const float wi1 = vc_[16 * j4 + r], em1 = vc_[64 + 16 * j4 + r];
            SCHED_FENCE();
            f32x4 dn = (f32x4){0.f, 0.f, 0.f, 0.f}, rsa = (f32x4){0.f, 0.f, 0.f, 0.f};
            const short one_ = (r == 0) ? (short)0x3F80 : (short)0;
            const s16x8 onesf = (s16x8){one_, one_, one_, one_, one_, one_, one_, one_};
            d2[0] = (f32x4){0.f, 0.f, 0.f, 0.f}; d2[1] = (f32x4){0.f, 0.f, 0.f, 0.f}; d3[0] = (f32x4){0.f, 0.f, 0.f, 0.f}; d3[1] = (f32x4){0.f, 0.f, 0.f, 0.f};
#pragma unroll
            for (int ks = 0; ks < 2; ++ks) { d2[0] = MFMA16(v0[ks], pf[ks], d2[0]); d2[1] = MFMA16(v1[ks], pf[ks], d2[1]); rsa = MFMA16(onesf, pf[ks], rsa); }
#pragma unroll
            for (int ks = 0; ks < 4; ++ks) { d3[0] = MFMA16(cfr[0][ks], qf[ks], d3[0]); d3[1] = MFMA16(cfr[1][ks], qf[ks], d3[1]); dn = MFMA16(nsf[ks], qf[ks], dn); }
            SCHED_FENCE();
            if (q == 0) denv[16 * j4 + r] = fmaxf(fabsf(rsa[0] + wi1 * qscale * dn[0]), em1);
        }
        LDS_BARRIER();
        if (prod) {
            if (n < T / 64) {
                int lrow = 16 * j4 + r; asm volatile("" : "+v"(lrow));
                s16x8 qf[4], fa[2][4]; f32x4 cf4[4];
                const v4u rvk = *(const LAS v4u*)(ML_V(n3) + st_off(vrow, vch * 8, 1));
#pragma unroll
                for (int ks = 0; ks < 4; ++ks) qf[ks] = ldfragS(ML_Q(n3), j4, ks, 4, lane);
#pragma unroll
                for (int si = 0; si < 2; ++si)
#pragma unroll
                    for (int ks = 0; ks < 4; ++ks) fa[si][ks] = ldfragS(ML_K(n3), si, ks, 4, lane);
                const float a_loc = ML_VEC(bb)[193], rf = rowfv[lrow];
                const float wv = colfv[vrow] * a_loc;
#pragma unroll
                for (int si = 0; si < 4; ++si) cf4[si] = *(const LAS f32x4*)(colfv + 16 * si + 4 * q);
                SCHED_FENCE();
                { float f8[8]; unpack8(rvk, f8);
#pragma unroll
                  for (int jj = 0; jj < 8; ++jj) f8[jj] *= wv;
                  *(LAS v4u*)(ML_VS(bb) + vrow * VSP + vch * 8) = pack8(f8);
                  if (vch == 0) { v4u o = (v4u){f2bf(wv), 0u, 0u, 0u}; *(LAS v4u*)(ML_VS(bb) + vrow * VSP + 32) = o; } }
                f32x4 d1[4];
#pragma unroll
                for (int si = 0; si < 4; ++si) d1[si] = (f32x4){0.f, 0.f, 0.f, 0.f};
#pragma unroll
                for (int ks = 0; ks < 4; ++ks)
#pragma unroll
                    for (int si = 0; si < 2; ++si) d1[si] = MFMA16(fa[si][ks], qf[ks], d1[si]);
                if (j4 >= 2) {
                    s16x8 fb[2][4];
#pragma unroll
                    for (int si = 0; si < 2; ++si)
#pragma unroll
                        for (int ks = 0; ks < 4; ++ks) fb[si][ks] = ldfragS(ML_K(n3), 2 + si, ks, 4, lane);
                    SCHED_FENCE();
#pragma unroll
                    for (int ks = 0; ks < 4; ++ks)
#pragma unroll
                        for (int si = 0; si < 2; ++si) d1[2 + si] = MFMA16(fb[si][ks], qf[ks], d1[2 + si]);
                }
                SCHED_FENCE();
#pragma unroll
                for (int si = 0; si < 4; ++si) { const int s0 = 16 * si + 4 * q; float v[4];
#pragma unroll
                    for (int i = 0; i < 4; ++i) v[i] = (s0 + i <= lrow) ? d1[si][i] * (rf * cf4[si][i]) : 0.f;
                    v2u o; o.x = pk2(v[0], v[1]); o.y = pk2(v[2], v[3]); *(LAS v2u*)(ML_P(bb) + lrow * LQ_ + s0) = o; }
            }
        } else if (c >= 0) {
            const LAS float* vc_ = ML_VEC(cb);
            s16x8 kf[2][2], vs[3][2];
#pragma unroll
            for (int et = 0; et < 2; ++et)
#pragma unroll
                for (int ks = 0; ks < 2; ++ks) kf[et][ks] = ldfrag_trS(ML_K(i3), 32 * ks, 16 * (2 * j4 + et), 4, lane);
#pragma unroll
            for (int t3 = 0; t3 < 3; ++t3)
#pragma unroll
                for (int ks = 0; ks < 2; ++ks) vs[t3][ks] = ldfrag_tr(ML_VS(cb), VSP, 32 * ks, 16 * t3, lane);
            const float wi1 = vc_[16 * j4 + r] * qscale, dn1 = denv[16 * j4 + r];
            const float a_old = vc_[192];
            SCHED_FENCE();
            if (c > 0) ML_STORE(c - 1);
#pragma unroll
            for (int et = 0; et < 2; ++et) { cst[et][0] = cst[et][0] * a_old; cst[et][1] = cst[et][1] * a_old; nreg[et] = nreg[et] * a_old; }
#pragma unroll
            for (int ks = 0; ks < 2; ++ks)
#pragma unroll
                for (int et = 0; et < 2; ++et) { cst[et][0] = MFMA16(kf[et][ks], vs[0][ks], cst[et][0]); cst[et][1] = MFMA16(kf[et][ks], vs[1][ks], cst[et][1]); nreg[et] = MFMA16(kf[et][ks], vs[2][ks], nreg[et]); }
            const float inv1 = __builtin_amdgcn_rcpf(dn1);
#pragma unroll
            for (int dvt = 0; dvt < 2; ++dvt) { float o4[4];
#pragma unroll
                for (int i = 0; i < 4; ++i) o4[i] = (d2[dvt][i] + wi1 * d3[dvt][i]) * inv1;
                ob[2 * dvt] = pk2(o4[0], o4[1]); ob[2 * dvt + 1] = pk2(o4[2], o4[3]); }
            SCHED_FENCE();
#pragma unroll
            for (int et = 0; et < 2; ++et) {
#pragma unroll
                for (int dvt = 0; dvt < 2; ++dvt) { v2u o; o.x = pk2(cst[et][dvt][0], cst[et][dvt][1]); o.y = pk2(cst[et][dvt][2], cst[et][dvt][3]);
                    *(LAS v2u*)(CS + (16 * dvt + r) * LP + 16 * (2 * j4 + et) + 4 * q) = o; }
                if (r == 0) { v2u o; o.x = pk2(nreg[et][0], nreg[et][1]); o.y = pk2(nreg[et][2], nreg[et][3]); *(LAS v2u*)(NS + 16 * (2 * j4 + et) + 4 * q) = o; } }
        }
        LDS_BARRIER();
        i3 = n3;
    }
    if (!prod) ML_STORE(T / 64 - 1);
}
#undef ML_LOAD
#undef ML_DMA
#undef ML_STORE
#undef ML_Q
#undef ML_K
#undef ML_P
#undef ML_V
#undef ML_VS
#undef ML_VEC
__device__ __forceinline__ s16x8 ldfrag72(const LAS bf16* base, int row0, int k0, int lane) {
    return *(const LAS s16x8*)(base + (row0 + (lane & 15)) * LQ + k0 + (lane >> 4) * 8);
}
__device__ __forceinline__ void scan_hg(const Args& a, unsigned char* ws, int l, LAS unsigned char* lds, int b, int h, int dq, int tid_in) {
    int tid = tid_in; asm volatile("" : "+v"(tid));
    const bf16* PROJ = (const bf16*)(ws + WS_PROJ); bf16* PROJW = (bf16*)(ws + WS_PROJ); const float* HGV = (const float*)(ws + WS_HGV);
#define HG_QM(X) (lds + (X) * 16384)
#define HG_KM(X) (lds + 49152 + (X) * 16384)
#define HG_V(X)  (lds + 98304 + (X) * 4096)
#define HG_P(X)  ((LAS bf16*)(lds + 110592 + (X) * 9216))
    LAS bf16* ST = (LAS bf16*)(lds + 129024);
#define HG_VEC(X) ((LAS float*)(lds + 137728 + (X) * 1536))
    const int lane = tid & 63, w = __builtin_amdgcn_readfirstlane(tid >> 6), q = lane >> 4, r = lane & 15;
    const bool prod = w < 4; const int j4 = w & 3, gt = tid & 255;
    f32x4 st[2][2];
#pragma unroll
    for (int kt = 0; kt < 2; ++kt) { st[kt][0] = (f32x4){0.f, 0.f, 0.f, 0.f}; st[kt][1] = (f32x4){0.f, 0.f, 0.f, 0.f}; }
    for (int i = tid; i < 32 * LP / 2; i += NTHR) ((LAS unsigned*)ST)[i] = 0u;
    float fv0 = 0.f, fv1 = 0.f;
#define HG_LOAD(cc) do { const size_t ch_ = (size_t)b * (T / 64) + (cc); \
        fv0 = HGV[(ch_ * 4 + h) * 384 + gt]; if (gt < 128) fv1 = HGV[(ch_ * 4 + h) * 384 + 256 + gt]; } while (0)
    const int dma_rr = lane >> 2, dma_cc = ((lane & 3) ^ ((lane >> 5) << 1)) * 8;
#define HG_DMA(cc, B3) do { const bf16* g_ = PROJ + ((size_t)b * T + (size_t)(cc) * 64 + 16 * j4 + dma_rr) * PJ + h * 128 + dma_cc; \
        _Pragma("unroll") for (int cg = 0; cg < 4; ++cg) { \
            dma16(g_ + C_GQ + 32 * cg, (unsigned)(size_t)(HG_QM(B3) + (j4 * 4 + cg) * 1024)); \
            dma16(g_ + C_GF + 32 * cg, (unsigned)(size_t)(HG_KM(B3) + (j4 * 4 + cg) * 1024)); } \
        dma16(g_ + C_GI + dq * 32, (unsigned)(size_t)(HG_V(B3) + j4 * 1024)); } while (0)
    unsigned ob[2][2] = {{0u, 0u}, {0u, 0u}};
#define HG_STORE(cc) do { bf16* op_ = PROJW + ((size_t)b * T + (size_t)(cc) * 64 + 16 * j4 + r) * PJ + C_GI + h * 128 + dq * 32 + 4 * q; \
        _Pragma("unroll") for (int dvt = 0; dvt < 2; ++dvt) { v2u o_; o_.x = ob[dvt][0]; o_.y = ob[dvt][1]; *(GAS v2u*)(op_ + 16 * dvt) = o_; } } while (0)
    if (prod) { HG_DMA(0, 0); HG_LOAD(0); }
    LDS_BARRIER();
    int i3 = 2;
#pragma unroll 1
    for (int c = -1; c < T / 64; ++c) {
        const int n = c + 1, bb = n & 1, cb = c & 1, n3 = (i3 == 2) ? 0 : i3 + 1, nn3 = (n3 == 2) ? 0 : n3 + 1;
        if (prod) {
            if (n < T / 64) {
                VM_WAIT();
                HG_VEC(bb)[gt] = fv0; if (gt < 128) HG_VEC(bb)[256 + gt] = fv1;
                if (n + 1 < T / 64) HG_DMA(n + 1, nn3);
                HG_LOAD((n + 1 < T / 64) ? n + 1 : n);
            }
        } else if (c >= 0) {
            const LAS float* vc_ = HG_VEC(cb);
            s16x8 pfr[2], qfr[4], vf0[2], vf1[2], s0f[4], s1f[4], kf[2][2]; f32x4 ev[2], ee[2];
#pragma unroll
            for (int ks = 0; ks < 2; ++ks) { pfr[ks] = ldfrag72(HG_P(cb), 16 * j4, 32 * ks, lane); vf0[ks] = ldfrag_trS(HG_V(i3), 32 * ks, 0, 1, lane); vf1[ks] = ldfrag_trS(HG_V(i3), 32 * ks, 16, 1, lane); }
#pragma unroll
            for (int kt = 0; kt < 2; ++kt)
#pragma unroll
                for (int ks = 0; ks < 2; ++ks) kf[kt][ks] = ldfrag_trS(HG_KM(i3), 32 * ks, 16 * (2 * j4 + kt), 4, lane);
#pragma unroll
            for (int ks = 0; ks < 4; ++ks) { qfr[ks] = ldfragS(HG_QM(i3), j4, ks, 4, lane); s0f[ks] = ldfrag(ST, 0, 32 * ks, lane); s1f[ks] = ldfrag(ST, 16, 32 * ks, lane); }
#pragma unroll
            for (int kt = 0; kt < 2; ++kt) { ev[kt] = *(const LAS f32x4*)(vc_ + 256 + 16 * (2 * j4 + kt) + 4 * q); ee[kt] = *(const LAS f32x4*)(vc_ + 128 + 16 * (2 * j4 + kt) + 4 * q); }
            SCHED_FENCE();
            f32x4 d0 = (f32x4){0.f, 0.f, 0.f, 0.f}, d1 = (f32x4){0.f, 0.f, 0.f, 0.f}, u[2][2];
#pragma unroll
            for (int kt = 0; kt < 2; ++kt) { u[kt][0] = (f32x4){0.f, 0.f, 0.f, 0.f}; u[kt][1] = (f32x4){0.f, 0.f, 0.f, 0.f}; }
#pragma unroll
            for (int ks = 0; ks < 2; ++ks) { d0 = MFMA16(vf0[ks], pfr[ks], d0); d1 = MFMA16(vf1[ks], pfr[ks], d1);
#pragma unroll
                for (int kt = 0; kt < 2; ++kt) { u[kt][0] = MFMA16(kf[kt][ks], vf0[ks], u[kt][0]); u[kt][1] = MFMA16(kf[kt][ks], vf1[ks], u[kt][1]); } }
#pragma unroll
            for (int ks = 0; ks < 4; ++ks) { d0 = MFMA16(s0f[ks], qfr[ks], d0); d1 = MFMA16(s1f[ks], qfr[ks], d1); }
            SCHED_FENCE();
            if (c > 0) HG_STORE(c - 1);
            ob[0][0] = pk2(d0[0], d0[1]); ob[0][1] = pk2(d0[2], d0[3]); ob[1][0] = pk2(d1[0], d1[1]); ob[1][1] = pk2(d1[2], d1[3]);
#pragma unroll
            for (int kt = 0; kt < 2; ++kt) { st[kt][0] = st[kt][0] * ev[kt] + u[kt][0] * ee[kt]; st[kt][1] = st[kt][1] * ev[kt] + u[kt][1] * ee[kt]; }
        }
        LDS_BARRIER();
        if (prod) {
            if (n < T / 64) {
                int lrow = 16 * j4 + r; asm volatile("" : "+v"(lrow));
                s16x8 qfr[4], kfr[4][4];
#pragma unroll
                for (int ks = 0; ks < 4; ++ks) qfr[ks] = ldfragS(HG_QM(n3), j4, ks, 4, lane);
#pragma unroll
                for (int si = 0; si < 4; ++si)
#pragma unroll
                    for (int ks = 0; ks < 4; ++ks) kfr[si][ks] = ldfragS(HG_KM(n3), si, ks, 4, lane);
                SCHED_FENCE();
                f32x4 d[4];
#pragma unroll
                for (int si = 0; si < 4; ++si) d[si] = (f32x4){0.f, 0.f, 0.f, 0.f};
#pragma unroll
                for (int ks = 0; ks < 4; ++ks)
#pragma unroll
                    for (int si = 0; si < 4; ++si) d[si] = MFMA16(kfr[si][ks], qfr[ks], d[si]);
                SCHED_FENCE();
#pragma unroll
                for (int si = 0; si < 4; ++si) { const int s0 = 16 * si + 4 * q; float v[4];
#pragma unroll
                    for (int i = 0; i < 4; ++i) v[i] = (s0 + i <= lrow) ? d[si][i] : 0.f;
                    v2u o; o.x = pk2(v[0], v[1]); o.y = pk2(v[2], v[3]); *(LAS v2u*)(HG_P(bb) + lrow * LQ + s0) = o; }
            }
        } else if (c >= 0) {
            const LAS float* vn_ = HG_VEC(bb);
#pragma unroll
            for (int kt = 0; kt < 2; ++kt) { const f32x4 en = (n < T / 64) ? *(const LAS f32x4*)(vn_ + 16 * (2 * j4 + kt) + 4 * q) : (f32x4){1.f, 1.f, 1.f, 1.f};
#pragma unroll
                for (int dvt = 0; dvt < 2; ++dvt) { const f32x4 sv = st[kt][dvt] * en; v2u o; o.x = pk2(sv[0], sv[1]); o.y = pk2(sv[2], sv[3]);
                    *(LAS v2u*)(ST + (16 * dvt + r) * LP + 16 * (2 * j4 + kt) + 4 * q) = o; } }
        }
        LDS_BARRIER();
        i3 = n3;
    }
    if (!prod) HG_STORE(T / 64 - 1);
#undef HG_STORE
#undef HG_LOAD
#undef HG_DMA
#undef HG_QM
#undef HG_KM
#undef HG_P
#undef HG_V
#undef HG_VEC
}

__device__ __forceinline__ void phase_post(const Args& a, unsigned char* ws, int l, int gw, int NGW, int lane) {
    bf16* PROJ = (bf16*)(ws + WS_PROJ); const bf16* SCR = (const bf16*)(ws + WS_SCR);
    const int c0 = lane * 8;
    {
        float snw0[8], snw1[8];
        { const float* p = a.in[I_SNW] + l * 1024;
#pragma unroll
          for (int e = 0; e < 8; ++e) { snw0[e] = p[c0 + e]; snw1[e] = p[512 + c0 + e]; } }
        for (int t = gw; t < M; t += 4 * NGW) {
            v4u ry0[4], rz0[4], ry1[4], rz1[4];
#pragma unroll
            for (int u = 0; u < 4; ++u) { const int tt = (t + u * NGW < M) ? t + u * NGW : t; const bf16* base = PROJ + (size_t)tt * PJ;
                ry0[u] = *(const GAS v4u*)(base + C_SX + c0); rz0[u] = *(const GAS v4u*)(base + C_SZ + c0); ry1[u] = *(const GAS v4u*)(base + C_SX + 512 + c0); rz1[u] = *(const GAS v4u*)(base + C_SZ + 512 + c0); }
#pragma unroll
            for (int u = 0; u < 4; ++u) { if (t + u * NGW < M) { bf16* base = PROJ + (size_t)(t + u * NGW) * PJ;
                float y0[8], z0[8], y1[8], z1[8]; unpack8(ry0[u], y0); unpack8(rz0[u], z0); unpack8(ry1[u], y1); unpack8(rz1[u], z1);
                float s0 = 0.f, s1 = 0.f;
#pragma unroll
                for (int e = 0; e < 8; ++e) { y0[e] *= siluf(z0[e]); y1[e] *= siluf(z1[e]); s0 += y0[e] * y0[e]; s1 += y1[e] * y1[e]; }
                const float r0 = __builtin_amdgcn_rsqf(wave_sum(s0) * (1.f / 512.f) + EPS), r1 = __builtin_amdgcn_rsqf(wave_sum(s1) * (1.f / 512.f) + EPS);
#pragma unroll
                for (int e = 0; e < 8; ++e) { y0[e] *= r0 * snw0[e]; y1[e] *= r1 * snw1[e]; }
                *(GAS v4u*)(base + C_SZ + c0) = pack8(y0); *(GAS v4u*)(base + C_SZ + 512 + c0) = pack8(y1); } }
        }
    }
    {
        float mnw[8], msk[8], cw[4][8], cbb[8];
#pragma unroll
        for (int e = 0; e < 8; ++e) { mnw[e] = a.in[I_MNW][l * 512 + c0 + e]; msk[e] = a.in[I_MSKIP][l * 512 + c0 + e]; cbb[e] = a.in[I_MCB][l * 512 + c0 + e];
#pragma unroll
            for (int j = 0; j < 4; ++j) cw[j][e] = a.in[I_MCW][(l * 4 + j) * 512 + c0 + e]; }
        for (int t = gw; t < M; t += 2 * NGW) {
            v4u rh[2], ro[2], rzz[2], rx[2][4];
#pragma unroll
            for (int u = 0; u < 2; ++u) { const int tt = (t + u * NGW < M) ? t + u * NGW : t; const bf16* base = PROJ + (size_t)tt * PJ; const int tl = tt % T;
                rh[u] = *(const GAS v4u*)(SCR + (size_t)tt * 1024 + c0); ro[u] = *(const GAS v4u*)(base + C_MO + c0); rzz[u] = *(const GAS v4u*)(base + C_MZ + c0);
#pragma unroll
                for (int j = 0; j < 4; ++j) rx[u][j] = (tl - 3 + j >= 0) ? *(const GAS v4u*)(PROJ + (size_t)(tt - 3 + j) * PJ + C_MX + c0) : (v4u){0u, 0u, 0u, 0u}; }
#pragma unroll
            for (int u = 0; u < 2; ++u) { if (t + u * NGW < M) { bf16* base = PROJ + (size_t)(t + u * NGW) * PJ;
                float hr[8], mo[8], mz[8]; unpack8(rh[u], hr); unpack8(ro[u], mo); unpack8(rzz[u], mz);
                float s = 0.f;
#pragma unroll
                for (int e = 0; e < 8; ++e) s += hr[e];
                s += __shfl_xor(s, 1); s += __shfl_xor(s, 2); s += __shfl_xor(s, 4); s += __shfl_xor(s, 8);
                const float mu = s * (1.f / 128.f); float q = 0.f;
#pragma unroll
                for (int e = 0; e < 8; ++e) { hr[e] -= mu; q += hr[e] * hr[e]; }
                q += __shfl_xor(q, 1); q += __shfl_xor(q, 2); q += __shfl_xor(q, 4); q += __shfl_xor(q, 8);
                const float rstd = __builtin_amdgcn_rsqf(q * (1.f / 128.f) + EPS);
                float mc[8];
#pragma unroll
                for (int e = 0; e < 8; ++e) mc[e] = cbb[e];
#pragma unroll
                for (int j = 0; j < 4; ++j) { float xj[8]; unpack8(rx[u][j], xj);
#pragma unroll
                    for (int e = 0; e < 8; ++e) mc[e] += cw[j][e] * xj[e]; }
                float y[8];
#pragma unroll
                for (int e = 0; e < 8; ++e) y[e] = (hr[e] * rstd * mnw[e] * sigm(mo[e]) + msk[e] * siluf(mc[e])) * siluf(mz[e]);
                *(GAS v4u*)(base + C_MZ + c0) = pack8(y); } }
        }
    }
    {
        float hnw[8];
#pragma unroll
        for (int e = 0; e < 8; ++e) hnw[e] = a.in[I_HNW][l * 512 + c0 + e];
        for (int t = gw; t < M; t += 4 * NGW) {
            v4u rr[4], rg[4];
#pragma unroll
            for (int u = 0; u < 4; ++u) { const int tt = (t + u * NGW < M) ? t + u * NGW : t; rr[u] = *(const GAS v4u*)(PROJ + (size_t)tt * PJ + C_GI + c0); rg[u] = *(const GAS v4u*)(PROJ + (size_t)tt * PJ + C_GZ + c0); }
#pragma unroll
            for (int u = 0; u < 4; ++u) { if (t + u * NGW < M) { float o[8], gz[8]; unpack8(rr[u], o); unpack8(rg[u], gz);
                float q = 0.f;
#pragma unroll
                for (int e = 0; e < 8; ++e) q += o[e] * o[e];
                q += __shfl_xor(q, 1); q += __shfl_xor(q, 2); q += __shfl_xor(q, 4); q += __shfl_xor(q, 8);
                const float rstd = __builtin_amdgcn_rsqf(q * (1.f / 128.f) + EPS);
#pragma unroll
                for (int e = 0; e < 8; ++e) o[e] = o[e] * rstd * hnw[e] * siluf(gz[e]);
                *(GAS v4u*)(PROJ + (size_t)(t + u * NGW) * PJ + C_GZ + c0) = pack8(o); } }
        }
    }
}
__device__ __forceinline__ void phase_final(float* X, const float* w, int gw, int NGW, int lane) {
    for (int m = gw; m < M; m += NGW) {
        GAS f32x4* xr = (GAS f32x4*)(X + (size_t)m * D) + lane; const GAS f32x4* wr = (const GAS f32x4*)w + lane;
        f32x4 v[4]; float s = 0.f;
#pragma unroll
        for (int j = 0; j < 4; ++j) { v[j] = xr[64 * j]; s += (v[j].x * v[j].x + v[j].y * v[j].y) + (v[j].z * v[j].z + v[j].w * v[j].w); }
        const float rstd = 1.0f / sqrtf(wave_sum(s) * (1.f / D) + EPS);
#pragma unroll
        for (int j = 0; j < 4; ++j) { const f32x4 ww = wr[64 * j]; xr[64 * j] = v[j] * rstd * ww; }
    }
}

constexpr int PH_PER_LAYER = 8, N_PHASES = DEPTH * PH_PER_LAYER + 1;
__device__ __forceinline__ unsigned char* fresh_ws() {
    typedef __attribute__((address_space(4))) const char cchar4;
    cchar4* ka = (cchar4*)__builtin_amdgcn_kernarg_segment_ptr();
    const unsigned long long raw_ = *(volatile __attribute__((address_space(4))) const unsigned long long*)(ka + __builtin_offsetof(Args, ws));
    return (unsigned char*)((__attribute__((address_space(1))) unsigned char*)raw_);
}
struct Ctx { int tid, lane, wave, G, bx, gw, NGW; };
template <int SUB>
__device__ __forceinline__ void run_phase(const Args& args, const int l, LAS unsigned char* lds, const Ctx c0, const int imask = 7) {
    Ctx c = c0; { int t_ = threadIdx.x; asm volatile("" : "+v"(t_)); c.tid = t_; c.lane = t_ & 63; }
    unsigned char* ws = fresh_ws();
    bf16* XN = (bf16*)(ws + WS_XN); bf16* PROJ = (bf16*)(ws + WS_PROJ);
    const float* Xin = (l == 0) ? args.in[I_X] : args.out;
    if constexpr (SUB == 8) {
        if (c.G != 256) phase_final(args.out, args.in[I_FNW], c.gw, c.NGW, c.lane);
    } else if constexpr (SUB == 0) {
        phase_weights(args, ws, l, lds, c.gw, c.NGW, c.wave, c.lane, c.bx, c.G, c.tid);
        if (l == 0 || c.G != 256) phase_norm(Xin, args.in[I_NORMW] + l * D, XN, c.gw, c.NGW, c.lane);
    } else if constexpr (SUB == 1) {
        pg8::Gemm g{XN, (const bf16*)(ws + WS_W1), D, D}; pg8::StaticOrder S; S.init(M, PJ, D, c.G, c.bx);
        pg8::EpiProj E{PROJ, PJ, (bf16*)(ws + WS_HALO), HALO_COLS, 0};
        pg8::gemm_phase<pg8::EpiProj, pg8::StaticOrder, true, true>(lds, g, S, E);
    } else if constexpr (SUB == 2) {
        for (int tile = c.bx; tile < M / 64; tile += c.G) phase_c0(args, ws, l, lds, tile, c.tid);
    } else if constexpr (SUB >= 10 && SUB <= 12) {
        for (int it = c.bx; it < 256; it += c.G) {
            if (SUB == 10 && it < 128) scan_ssd(args, ws, l, lds, it >> 5, (it >> 1) & 15, it & 1, c.tid);
            else if (SUB == 11 && it >= 128 && it < 192) scan_ml(args, ws, l, lds, (it - 128) >> 4, ((it - 128) >> 2) & 3, (it - 128) & 3, c.tid);
            else if (SUB == 12 && it >= 192) scan_hg(args, ws, l, lds, (it - 192) >> 4, ((it - 192) >> 2) & 3, (it - 192) & 3, c.tid);
        }
    } else if constexpr (SUB == 13) {
        phase_post(args, ws, l, c.gw, c.NGW, c.lane);
    } else if constexpr (SUB == 14) {
        phase_norm(Xin, args.in[I_NORMW] + l * D, XN, c.gw, c.NGW, c.lane);
    } else if constexpr (SUB == 3) {
        for (int u = c.bx; u < 256; u += c.G) {
            const int xcd = u & 7, slot = u >> 3;
            if (slot < 16) { if (imask & 1) scan_ssd(args, ws, l, lds, xcd >> 1, (xcd & 1) * 8 + (slot >> 1), slot & 1, c.tid); }
            else if (slot < 24) { const int gi = xcd * 2 + ((slot - 16) >> 2); if (imask & 2) scan_ml(args, ws, l, lds, gi >> 2, gi & 3, slot & 3, c.tid); }
            else { const int gi = xcd * 2 + ((slot - 24) >> 2); if (imask & 4) scan_hg(args, ws, l, lds, gi >> 2, gi & 3, slot & 3, c.tid); }
        }
    } else if constexpr (SUB == 4) {
        if (imask & 1) phase_post(args, ws, l, c.gw, c.NGW, c.lane);
        if ((imask & 2) && c.G != 256) phase_norm(Xin, args.in[I_NORMW] + l * D, XN, c.gw, c.NGW, c.lane);
    } else if constexpr (SUB == 5) {
        pg8::Gemm g{XN, (const bf16*)(ws + WS_W2), D, D}; pg8::StaticOrder S; S.init(M, 3072, D, c.G, c.bx);
        pg8::EpiProj E{PROJ, PJ, nullptr, 0, 1};
        pg8::gemm_phase<pg8::EpiProj, pg8::StaticOrder, true, true>(lds, g, S, E);
    } else if constexpr (SUB == 6) {
        pg8::Gemm g{PROJ + C_SZ, (const bf16*)(ws + WS_WBR), PJ, 2048}; pg8::BranchOrder S; S.init(M, D, c.G, c.bx);
        pg8::EpiMerge E{XN, D, PROJ, PJ};
        pg8::gemm_phase<pg8::EpiMerge, pg8::BranchOrder, true, true>(lds, g, S, E);
    } else if constexpr (SUB == 7) {
        pg8::Gemm g{XN, (const bf16*)(ws + WS_WOUT), D, D}; pg8::StaticOrder S; S.init(M, D, D, c.G, c.bx);
        {
            const bool last = (l == DEPTH - 1);
            pg8::EpiResidNorm E{Xin, args.out, D, last ? args.in[I_FNW] : args.in[I_NORMW] + (l + 1) * D, XN, (unsigned*)(ws + WS_XBUF) + (size_t)l * M * 4,
                                (unsigned*)(ws + WS_CTL) + CW_PANEL + l * 4096, last ? 1 : 0, EPS};
            pg8::gemm_phase<pg8::EpiResidNorm, pg8::StaticOrder, false, true>(lds, g, S, E);
        }
    }
}
__device__ __forceinline__ Ctx make_ctx() {
    Ctx c; c.tid = threadIdx.x; c.lane = c.tid & 63; c.wave = __builtin_amdgcn_readfirstlane(c.tid >> 6);
    c.G = gridDim.x; c.bx = blockIdx.x;
    const int vcu = (c.G % 8 == 0) ? (c.bx % 8) * (c.G / 8) + c.bx / 8 : c.bx;
    c.gw = vcu * NWAVES + c.wave; c.NGW = c.G * NWAVES; return c;
}
template <int SUB>
__global__ void __launch_bounds__(NTHR, 2) fwd_single(Args args, int l) {
    extern __shared__ __attribute__((aligned(16))) unsigned char lds_raw[];
    LAS unsigned char* lds = (LAS unsigned char*)lds_raw;
    const Ctx c = make_ctx();
    run_phase<SUB>(args, l, lds, c);
}
#if !MK_PER_PHASE
__global__ void __launch_bounds__(NTHR, 2) fwd_all(Args args) {
    extern __shared__ __attribute__((aligned(16))) unsigned char lds_raw[];
    LAS unsigned char* lds = (LAS unsigned char*)lds_raw;
    const Ctx c = make_ctx();
    volatile LAS unsigned* MISC = (volatile LAS unsigned*)(lds + MISC_OFF);
    if (c.tid < 32) MISC[c.tid] = 0u;
    __syncthreads();
    const XcdBarrier bar = xcd_barrier_post((unsigned*)(fresh_ws() + WS_CTL) + CW_BAR, MISC + 8);
#pragma unroll 1
    for (int it = 0; it < DEPTH + (PROBE_K > 0 ? 1 : 0); ++it) {
        const bool probe = (PROBE_K > 0) && it == 0;
        const int l = (PROBE_K > 0) ? (it == 0 ? 0 : it - 1) : it;
        const int kmax = probe ? PROBE_K : 8;
        const int im = probe ? PROBE_IMASK : 7;
        if (0 < kmax) { run_phase<0>(args, l, lds, c); xcd_barrier(bar); }
        if (1 < kmax) { run_phase<1>(args, l, lds, c); xcd_barrier(bar); }
        if (2 < kmax) { run_phase<2>(args, l, lds, c); xcd_barrier(bar); }
        if (3 < kmax) { run_phase<3>(args, l, lds, c, im); xcd_barrier(bar); }
        if (4 < kmax) { run_phase<4>(args, l, lds, c, im); xcd_barrier(bar); }
        if (5 < kmax) { run_phase<5>(args, l, lds, c); xcd_barrier(bar); }
        if (6 < kmax) { run_phase<6>(args, l, lds, c); xcd_barrier(bar); }
        if (7 < kmax) { run_phase<7>(args, l, lds, c); if (l + 1 < DEPTH || c.G != 256) xcd_barrier(bar); }
    }
    if constexpr ((FMASK >> 8) & 1) run_phase<8>(args, 0, lds, c);
}
#endif

template <int SUB> static void launch_single(int grid, hipStream_t stream, const Args& a, int l) {
    static bool attr_done = false;
    if (!attr_done) { (void)hipFuncSetAttribute((const void*)fwd_single<SUB>, hipFuncAttributeMaxDynamicSharedMemorySize, LDS_BYTES); attr_done = true; }
    hipLaunchKernelGGL(fwd_single<SUB>, dim3(grid), dim3(NTHR), LDS_BYTES, stream, a, l);
}
extern "C" void kernel_launch(void* const* d_in, const int* in_sizes, int n_in, void* d_out, int out_size, void* d_ws, size_t ws_size, hipStream_t stream) {
    static int grid = 0;
    if (grid == 0) {
        if (n_in != 25 || in_sizes[0] != M * D || out_size != M * D || ws_size < WS_END) { fprintf(stderr, "kernel_launch: unexpected shapes (n_in %d, in0 %d, out %d, ws %zu)\n", n_in, n_in > 0 ? in_sizes[0] : -1, out_size, ws_size); grid = -1; return; }
        int dev = 0, cus = 0;
        if (hipGetDevice(&dev) != hipSuccess || hipDeviceGetAttribute(&cus, hipDeviceAttributeMultiprocessorCount, dev) != hipSuccess) { grid = -1; return; }
#if !MK_PER_PHASE
        int per_cu = 0;
        if (hipFuncSetAttribute((const void*)fwd_all, hipFuncAttributeMaxDynamicSharedMemorySize, LDS_BYTES) != hipSuccess) { fprintf(stderr, "kernel_launch: hipFuncSetAttribute failed\n"); grid = -1; return; }
        if (hipOccupancyMaxActiveBlocksPerMultiprocessor(&per_cu, (const void*)fwd_all, NTHR, LDS_BYTES) != hipSuccess || per_cu < 1)
            fprintf(stderr, "kernel_launch: occupancy query reports %d workgroups per CU\n", per_cu);
#endif
        (void)hipGetLastError();
        if (cus != 256) { fprintf(stderr, "kernel_launch: this kernel's fused epilogues and buffer layout need exactly 256 workgroups (one per CU); device reports %d CUs\n", cus); grid = -1; return; }
        static_assert(DEPTH == 2, "the bf16 residual / parked q|k layout of the output buffer is written for two layers");
        grid = cus;
    }
    if (grid < 0) return;
    Args a{};
    for (int i = 0; i < 25; ++i) a.in[i] = (const float*)d_in[i];
    a.out = (float*)d_out; a.ws = (unsigned char*)d_ws; a.ph_lo = 0; a.ph_hi = N_PHASES;
#if MK_PER_PHASE
#if PROBE_K > 0
    launch_single<0>(grid, stream, a, 0);
#endif
#if PROBE_K > 1
    launch_single<1>(grid, stream, a, 0);
#endif
#if PROBE_K > 2
    launch_single<2>(grid, stream, a, 0);
#endif
#if PROBE_K > 3
    launch_single<PROBE_SCAN>(grid, stream, a, 0);
#endif
#if PROBE_K > 4
    launch_single<PROBE_POST>(grid, stream, a, 0);
#endif
#if PROBE_K > 5
    launch_single<5>(grid, stream, a, 0);
#endif
#if PROBE_K > 6
    launch_single<6>(grid, stream, a, 0);
#endif
    for (int l = 0; l < DEPTH; ++l) {
        launch_single<0>(grid, stream, a, l); launch_single<1>(grid, stream, a, l); launch_single<2>(grid, stream, a, l); launch_single<3>(grid, stream, a, l);
        launch_single<4>(grid, stream, a, l); launch_single<5>(grid, stream, a, l); launch_single<6>(grid, stream, a, l); launch_single<7>(grid, stream, a, l);
    }
    launch_single<8>(grid, stream, a, 0);
#else
    (void)hipMemsetAsync((char*)d_ws + WS_CTL, 0, CTL_ZERO_BYTES, stream);
    hipLaunchKernelGGL(fwd_all, dim3(grid), dim3(NTHR), LDS_BYTES, stream, a);
#endif
    const hipError_t le = hipPeekAtLastError();
    if (le != hipSuccess) fprintf(stderr, "kernel_launch: launch failed: %s\n", hipGetErrorName(le));
}
```
